# Optimizing an MI355X kernel written in HIP

```python
import jax, jax.numpy as jnp
from jax import lax
import numpy as np

D_MODEL = 2048
BATCH = 2
SEQ = 8192
DEPTH = 4

CTX_LEN = 256
GRID_W = 64
N_MIXERS = 2
N_A_LAYERS = (DEPTH + N_MIXERS - 1) // N_MIXERS
N_B_LAYERS = DEPTH // N_MIXERS
HG_EXPAND = 128
HG_HEADS = D_MODEL // HG_EXPAND
HG_DK = HG_EXPAND
HG_DV = D_MODEL // HG_HEADS
HG_CHUNK = 16
RNN_WIDTH = D_MODEL
RG_BLOCK = 256
RG_BLOCKS = RNN_WIDTH // RG_BLOCK
RG_C = 8.0
CONV_W = 4
CONV_LEFT = 2
D_FF = 4 * D_MODEL
N_MOD = 6
EPS = 1e-6

kernel_name = 'hybrid_hgrn2_rglru_prefix_dit'


def _rmsnorm(x, gain):
    x32 = x.astype(jnp.float32)
    y = x32 * lax.rsqrt(jnp.mean(jnp.square(x32), axis=-1, keepdims=True) + EPS)
    return (y * gain.astype(jnp.float32)).astype(x.dtype)


def _modulate(h, shift, scale):
    return h * (1 + scale) + shift


def _seg_reverse(t, n_ctx):
    return jnp.concatenate([jnp.flip(t[:, :n_ctx], 1), jnp.flip(t[:, n_ctx:], 1)], axis=1)


def _gla_chunk_scan(q, k, logf, v):
    bsz, T, H, dk = q.shape
    dv = v.shape[-1]
    n = T // HG_CHUNK

    def chunks(t):
        return jnp.swapaxes(t.reshape(bsz, n, HG_CHUNK, H, t.shape[-1]), 0, 1)

    tri = jnp.tril(jnp.ones((HG_CHUNK, HG_CHUNK), dtype=bool))[None, :, :, None, None]

    def step(S, inp):
        qc, kc, gc, vc = inp
        b = jnp.cumsum(gc, axis=1)
        w = jnp.exp(jnp.where(tri, b[:, :, None] - b[:, None, :], -jnp.inf))
        A = jnp.einsum('bthd,bshd,btshd->bhts', qc, kc, w)
        o = jnp.einsum('bhts,bshv->bthv', A, vc) + jnp.einsum('bthd,bhdv->bthv', qc * jnp.exp(b), S)
        b_last = b[:, -1]
        S = jnp.exp(b_last)[..., None] * S + jnp.einsum(
            'bshd,bshv->bhdv', kc * jnp.exp(b_last[:, None] - b), vc)
        return S, o

    S0 = jnp.zeros((bsz, H, dk, dv), jnp.float32)
    _, o = lax.scan(step, S0, (chunks(q), chunks(k), chunks(logf), chunks(v)))
    return jnp.swapaxes(o, 0, 1).reshape(bsz, T, H, dv)


def _hgrn2_mixer(h_ctx, h_lat, w_in, lb, onorm, w_out):
    n_ctx = h_ctx.shape[1]
    h = jnp.concatenate([h_ctx, h_lat], axis=1)
    bsz, T, _ = h.shape
    q, v, g, z_f, z_b = jnp.split(h @ w_in, 5, axis=-1)

    def heads(t, d):
        return t.astype(jnp.float32).reshape(bsz, T, HG_HEADS, d)

    ident = lambda t: t
    rev = lambda t: _seg_reverse(t, n_ctx)
    o = jnp.zeros((bsz, T, HG_HEADS, HG_DV), jnp.float32)
    for z, lb_d, order in ((z_f, lb[0], ident), (z_b, lb[1], rev)):
        z32 = order(z).astype(jnp.float32)
        logf = jnp.logaddexp(jnp.log(lb_d), jnp.log1p(-lb_d) + jax.nn.log_sigmoid(z32))
        k = (1.0 - lb_d) * jax.nn.sigmoid(-z32)
        o_d = _gla_chunk_scan(heads(order(q), HG_DK), heads(k, HG_DK),
                              heads(logf, HG_DK), heads(order(v), HG_DV))
        o = o + order(o_d)
    o = o * lax.rsqrt(jnp.mean(jnp.square(o), axis=-1, keepdims=True) + EPS)
    o = o.reshape(bsz, T, D_MODEL) * onorm.astype(jnp.float32) * jax.nn.silu(g.astype(jnp.float32))
    out = o.astype(h.dtype) @ w_out
    return out[:, :n_ctx], out[:, n_ctx:]


def _centred_dwconv(u, w, b):
    T = u.shape[1]
    up = jnp.pad(u, ((0, 0), (CONV_LEFT, CONV_W - 1 - CONV_LEFT), (0, 0)))
    return sum(w[j] * up[:, j:j + T] for j in range(CONV_W)) + b


def _linear_scan(a, b):
    def combine(l, r):
        return l[0] * r[0], r[0] * l[1] + r[1]
    return lax.associative_scan(combine, (a, b), axis=1)[1]


def _rglru_mixer(h_ctx, h_lat, w_in, conv_w, conv_b, gate_w, gate_b, lam, w_out):
    n_ctx = h_ctx.shape[1]
    h = jnp.concatenate([h_ctx, h_lat], axis=1)
    bsz, T, _ = h.shape
    y, u = jnp.split(h @ w_in, 2, axis=-1)
    u = jnp.concatenate([_centred_dwconv(u[:, :n_ctx], conv_w, conv_b),
                         _centred_dwconv(u[:, n_ctx:], conv_w, conv_b)], axis=1)
    u_blk = u.reshape(bsz, T, RG_BLOCKS, RG_BLOCK)
    u32 = u.astype(jnp.float32)

    def block_gate(d, gi):
        z = jnp.einsum('btnj,njk->btnk', u_blk, gate_w[d, gi]).reshape(bsz, T, RNN_WIDTH) + gate_b[d, gi]
        return jax.nn.sigmoid(z.astype(jnp.float32))

    ident = lambda t: t
    rev = lambda t: _seg_reverse(t, n_ctx)
    hsum = jnp.zeros((bsz, T, RNN_WIDTH), jnp.float32)
    for d, order in ((0, ident), (1, rev)):
        r_gate = block_gate(d, 0)
        i_gate = block_gate(d, 1)
        log_a = -RG_C * jax.nn.softplus(-lam[d].astype(jnp.float32)) * r_gate
        x_in = jnp.sqrt(-jnp.expm1(2.0 * log_a)) * (i_gate * u32)
        hsum = hsum + order(_linear_scan(order(jnp.exp(log_a)), order(x_in)))
    out = (jax.nn.gelu(y.astype(jnp.float32), approximate=True) * hsum).astype(h.dtype) @ w_out
    return out[:, :n_ctx], out[:, n_ctx:]


def _mlp(h, w1, w2):
    return jnp.square(jax.nn.relu(h @ w1)) @ w2


def setup_inputs(seed: int = 0) -> dict:
    key = jax.random.key(seed)
    ks = jax.random.split(key, 24)
    D = D_MODEL

    def nrm(k, shape, scale):
        return jax.random.normal(k, shape, jnp.float32) * scale

    r = jax.random.uniform(ks[17], (N_B_LAYERS, 2, RNN_WIDTH), jnp.float32, 0.9, 0.999)
    a_root = r ** (1.0 / RG_C)
    b_lambda = jnp.log(a_root) - jnp.log1p(-a_root)
    return {
        'x': nrm(ks[0], (BATCH, SEQ, D), 1.0),
        'c': nrm(ks[1], (BATCH, D), 1.0),
        'ctx': nrm(ks[2], (BATCH, CTX_LEN, D), 1.0),
        'c_ctx': nrm(ks[3], (D,), 1.0),
        'w_mod': nrm(ks[4], (DEPTH, D, N_MOD * D), 0.5 * D ** -0.5),
        'b_mod': nrm(ks[5], (DEPTH, N_MOD * D), 0.02),
        'norm1': 1.0 + nrm(ks[6], (DEPTH, D), 0.02),
        'norm2': 1.0 + nrm(ks[7], (DEPTH, D), 0.02),
        'a_w_in': nrm(ks[8], (N_A_LAYERS, D, 5 * D), D ** -0.5),
        'a_lb_logits': nrm(ks[9], (N_A_LAYERS, 2, HG_HEADS * HG_DK), 0.5),
        'a_onorm': 1.0 + nrm(ks[10], (N_A_LAYERS, D), 0.02),
        'a_w_out': nrm(ks[11], (N_A_LAYERS, D, D), D ** -0.5),
        'b_w_in': nrm(ks[12], (N_B_LAYERS, D, 2 * RNN_WIDTH), D ** -0.5),
        'b_conv_w': nrm(ks[13], (N_B_LAYERS, CONV_W, RNN_WIDTH), CONV_W ** -0.5),
        'b_conv_b': nrm(ks[14], (N_B_LAYERS, RNN_WIDTH), 0.02),
        'b_gate_w': nrm(ks[15], (N_B_LAYERS, 2, 2, RG_BLOCKS, RG_BLOCK, RG_BLOCK), RG_BLOCK ** -0.5),
        'b_gate_b': nrm(ks[16], (N_B_LAYERS, 2, 2, RNN_WIDTH), 0.02),
        'b_lambda': b_lambda,
        'b_w_out': nrm(ks[18], (N_B_LAYERS, RNN_WIDTH, D), RNN_WIDTH ** -0.5),
        'mlp_w1': nrm(ks[19], (DEPTH, D, D_FF), D ** -0.5),
        'mlp_w2': nrm(ks[20], (DEPTH, D_FF, D), D_FF ** -0.5),
        'final_norm': 1.0 + nrm(ks[21], (D,), 0.02),
    }


def reference(x, c, ctx, c_ctx, w_mod, b_mod, norm1, norm2, a_w_in, a_lb_logits, a_onorm, a_w_out,
              b_w_in, b_conv_w, b_conv_b, b_gate_w, b_gate_b, b_lambda, b_w_out, mlp_w1, mlp_w2,
              final_norm):
    p = jax.nn.softmax(a_lb_logits.astype(jnp.float32), axis=0)
    lb_all = jnp.cumsum(p, axis=0) - p[0]
    silu_c = jax.nn.silu(c)
    silu_cc = jax.nn.silu(c_ctx)
    for layer in range(DEPTH):
        sh1, sc1, g1, sh2, sc2, g2 = jnp.split((silu_c @ w_mod[layer] + b_mod[layer])[:, None, :], N_MOD, axis=-1)
        csh1, csc1, cg1, csh2, csc2, cg2 = jnp.split(silu_cc @ w_mod[layer] + b_mod[layer], N_MOD, axis=-1)
        h_lat = _modulate(_rmsnorm(x, norm1[layer]), sh1, sc1)
        h_ctx = _modulate(_rmsnorm(ctx, norm1[layer]), csh1, csc1)
        j = layer // N_MIXERS
        if layer % N_MIXERS == 0:
            o_ctx, o_lat = _hgrn2_mixer(h_ctx, h_lat, a_w_in[j], lb_all[j], a_onorm[j], a_w_out[j])
        else:
            o_ctx, o_lat = _rglru_mixer(h_ctx, h_lat, b_w_in[j], b_conv_w[j], b_conv_b[j], b_gate_w[j],
                                        b_gate_b[j], b_lambda[j], b_w_out[j])
        x = x + g1 * o_lat
        x = x + g2 * _mlp(_modulate(_rmsnorm(x, norm2[layer]), sh2, sc2), mlp_w1[layer], mlp_w2[layer])
        if layer < DEPTH - 1:
            ctx = ctx + cg1 * o_ctx
            ctx = ctx + cg2 * _mlp(_modulate(_rmsnorm(ctx, norm2[layer]), csh2, csc2),
                                   mlp_w1[layer], mlp_w2[layer])
    return _rmsnorm(x, final_norm)
```

```cpp
#include <hip/hip_runtime.h>
#include <cstdio>
#include <cstdint>
namespace pg8 {
#define PG8_LAS __attribute__((address_space(3)))
typedef unsigned short bf16_t;
typedef short bf16x8 __attribute__((ext_vector_type(8)));
typedef float f32x4 __attribute__((ext_vector_type(4)));
typedef unsigned u32x4 __attribute__((ext_vector_type(4)));
constexpr int BM = 256, BK = 64, HALF = 128, HTB = HALF * BK * 2  , STAGE_BYTES = 8 * HTB, NXCD = 8, WGM = 8;

__host__ __device__ __forceinline__ int lds_byte(int r, int c) { const int st = (r >> 4) * 2 + (c >> 5), rr = r & 15, cc = c & 31, ob = rr * 64 + cc * 2; return st * 1024 + (ob ^ (((ob >> 9) & 1) << 5)); }
__host__ __device__ __forceinline__ void stage_rc(int b, int& R, int& C) { const int st = b / 1024, sb = b % 1024, swz = sb ^ (((sb >> 9) & 1) << 5); R = (st >> 1) * 16 + swz / 64; C = (st & 1) * 32 + (swz % 64) / 2; }
__host__ __device__ __forceinline__ int perm32(int rho) { const int n = rho >> 4, i = rho & 15; return 8 * (i >> 2) + 4 * n + (i & 3); }

struct Unit { int pm, pn; };
struct Gemm { const bf16_t* A; const bf16_t* Bt; int M, N, K, lda; };

struct StaticOrder {
    int nM, nN, nwg, G, c;
    __host__ __device__ void init(int M, int N, int G_, int c_) { nM = M / BM; nN = N / BM; nwg = nM * nN; G = G_; c = c_; }
    __host__ __device__ bool next(int i, Unit& u) const {
        const long L = (long)i * G + c; if (L >= nwg) return false;
        int wgid = (int)L; { const int q = nwg / NXCD, r = nwg % NXCD, xcd = wgid % NXCD, off = wgid / NXCD; wgid = (xcd < r ? xcd * (q + 1) : r * (q + 1) + (xcd - r) * q) + off; }
        const int nig = WGM * nN, gid = wgid / nig, fm = gid * WGM, gsz = (nM - fm) < WGM ? (nM - fm) : WGM;
        u.pm = fm + ((wgid % nig) % gsz); u.pn = (wgid % nig) / gsz; return true;
    }
    __device__ __forceinline__ void a_ready(const Unit&) const {}
    __device__ __forceinline__ int a_koff(const Unit&) const { return 0; }
    __device__ __forceinline__ void done(const Unit&) const {}
};


typedef float f32x2 __attribute__((ext_vector_type(2)));
typedef __bf16 bf16x2v __attribute__((ext_vector_type(2)));
__device__ __forceinline__ unsigned pk2(float lo, float hi) { f32x2 v = {lo, hi}; bf16x2v b = __builtin_convertvector(v, bf16x2v); return __builtin_bit_cast(unsigned, b); }
__device__ __forceinline__ u32x4 pk8(const f32x4& a, const f32x4& b) { u32x4 w; w.x = pk2(a[0], a[1]); w.y = pk2(a[2], a[3]); w.z = pk2(b[0], b[1]); w.w = pk2(b[2], b[3]); return w; }
__device__ __forceinline__ float bflo(unsigned w) { return __uint_as_float(w << 16); }
__device__ __forceinline__ float bfhi(unsigned w) { return __uint_as_float(w & 0xffff0000u); }
constexpr int ROWS = 16896, DM = 2048;
__device__ __forceinline__ int grp_of_pm(int pm) { return pm < 2 ? 0 : (pm < 34 ? 1 : 2); }
__device__ __forceinline__ float sigmoidf_(float z) { return 1.0f / (1.0f + __expf(-z)); }
__device__ __forceinline__ float one_minus_exp(float x) {
    const float p = -x * (1.0f + x * (0.5f + x * (0.16666667f + x * (0.041666668f + x * (0.0083333338f + x * 0.0013888889f)))));
    return x < -0.25f ? 1.0f - __expf(x) : fmaxf(p, 0.f);
}
__device__ __forceinline__ float row_rstd(const float* ssq, int row, int fq) {
    const f32x4 a = *(const f32x4*)(ssq + (size_t)row * 32 + fq * 8), b = *(const f32x4*)(ssq + (size_t)row * 32 + fq * 8 + 4);
    float s = ((a[0] + a[1]) + (a[2] + a[3])) + ((b[0] + b[1]) + (b[2] + b[3]));
    s += __shfl_xor(s, 16); s += __shfl_xor(s, 32);
    return 1.0f / sqrtf(s * (1.0f / 2048.0f) + 1e-6f);
}

struct EpiA1 {
    static constexpr bool PERM = true, AFTER_DRAIN = false;
    const float* ssq; const float* bias; const float* lb; bf16_t* Q; bf16_t* V; bf16_t* SG; float* LF;
    __device__ __forceinline__ void operator()(const f32x4 (&acc)[2][2][4][2], const Unit& u, int wr, int wc, int fr0, int fq0) const {
        int fr = fr0, fq = fq0; asm volatile("" : "+v"(fr), "+v"(fq));
        const int row0 = u.pm * BM + wr * 64 + fr, kind = u.pn >> 3, ct = (u.pn & 7) * BM + wc * 32 + 8 * fq, bcol = u.pn * BM + wc * 32 + 8 * fq;
        const float* bp = bias + grp_of_pm(u.pm) * 10240 + bcol;
        f32x4 bv[2][2], lbv[2][2];
#pragma unroll
        for (int bj = 0; bj < 2; ++bj)
#pragma unroll
            for (int n = 0; n < 2; ++n) { bv[bj][n] = *(const f32x4*)(bp + bj * HALF + 4 * n);
                lbv[bj][n] = kind >= 3 ? *(const f32x4*)(lb + (kind - 3) * DM + ct + bj * HALF + 4 * n) : (f32x4){0.f, 0.f, 0.f, 0.f}; }
#pragma unroll
        for (int ai = 0; ai < 2; ++ai)
#pragma unroll
            for (int m = 0; m < 4; ++m) { const int row = row0 + ai * HALF + m * 16; const float rs = row_rstd(ssq, row, fq);
#pragma unroll
                for (int bj = 0; bj < 2; ++bj) { f32x4 v0 = acc[ai][bj][m][0] * rs + bv[bj][0], v1 = acc[ai][bj][m][1] * rs + bv[bj][1];
                    const size_t off = (size_t)row * DM + ct + bj * HALF;
                    if (kind == 0) { *(u32x4*)(Q + off) = pk8(v0, v1); }
                    else if (kind == 1) { *(u32x4*)(V + off) = pk8(v0, v1); }
                    else if (kind == 2) {
#pragma unroll
                        for (int e = 0; e < 4; ++e) { v0[e] = v0[e] * sigmoidf_(v0[e]); v1[e] = v1[e] * sigmoidf_(v1[e]); }
                        *(u32x4*)(SG + off) = pk8(v0, v1); }
                    else {
#pragma unroll
                        for (int e = 0; e < 4; ++e) {
                            { const float z = v0[e], ez = __expf(-fabsf(z)), s = (z >= 0.f ? 1.0f : ez) / (1.0f + ez), l = lbv[bj][0][e]; v0[e] = fmaxf(__logf(l + (1.0f - l) * s), -80.0f); }
                            { const float z = v1[e], ez = __expf(-fabsf(z)), s = (z >= 0.f ? 1.0f : ez) / (1.0f + ez), l = lbv[bj][1][e]; v1[e] = fmaxf(__logf(l + (1.0f - l) * s), -80.0f); } }
                        float* lp = LF + (size_t)(kind - 3) * ROWS * DM + off; *(f32x4*)lp = v0; *(f32x4*)(lp + 4) = v1; } } }
    }
};
struct EpiRes {
    static constexpr bool PERM = true, AFTER_DRAIN = false;
    float* X; const float* gate; const float* gm; bf16_t* XM; float* ssq;
    __device__ __forceinline__ void operator()(const f32x4 (&acc)[2][2][4][2], const Unit& u, int wr, int wc, int fr0, int fq0) const {
        int fr = fr0, fq = fq0; asm volatile("" : "+v"(fr), "+v"(fq));
        const int row0 = u.pm * BM + wr * 64 + fr, col0 = u.pn * BM + wc * 32 + 8 * fq, grp = grp_of_pm(u.pm);
        f32x4 gv[2][2], mv[2][2];
#pragma unroll
        for (int bj = 0; bj < 2; ++bj)
#pragma unroll
            for (int n = 0; n < 2; ++n) { gv[bj][n] = *(const f32x4*)(gate + grp * 12288 + col0 + bj * HALF + 4 * n); mv[bj][n] = *(const f32x4*)(gm + grp * DM + col0 + bj * HALF + 4 * n); }
#pragma unroll
        for (int ai = 0; ai < 2; ++ai)
#pragma unroll
            for (int m = 0; m < 4; ++m) { const int row = row0 + ai * HALF + m * 16; float ss = 0.f;
#pragma unroll
                for (int bj = 0; bj < 2; ++bj) { float* xp = X + (size_t)row * DM + col0 + bj * HALF;
                    const f32x4 n0 = *(const f32x4*)xp + gv[bj][0] * acc[ai][bj][m][0], n1 = *(const f32x4*)(xp + 4) + gv[bj][1] * acc[ai][bj][m][1];
                    *(f32x4*)xp = n0; *(f32x4*)(xp + 4) = n1;
                    ss += ((n0[0] * n0[0] + n0[1] * n0[1]) + (n0[2] * n0[2] + n0[3] * n0[3])) + ((n1[0] * n1[0] + n1[1] * n1[1]) + (n1[2] * n1[2] + n1[3] * n1[3]));
                    *(u32x4*)(XM + (size_t)row * DM + col0 + bj * HALF) = pk8(n0 * mv[bj][0], n1 * mv[bj][1]); }
                ss += __shfl_xor(ss, 16); ss += __shfl_xor(ss, 32);
                if (fq == 0) ssq[(size_t)row * 32 + u.pn * 4 + wc] = ss; }
    }
};
struct EpiMlp1 {
    static constexpr bool PERM = true, AFTER_DRAIN = false;
    const float* ssq; const float* bias; bf16_t* H;
    __device__ __forceinline__ void operator()(const f32x4 (&acc)[2][2][4][2], const Unit& u, int wr, int wc, int fr0, int fq0) const {
        int fr = fr0, fq = fq0; asm volatile("" : "+v"(fr), "+v"(fq));
        const int row0 = u.pm * BM + wr * 64 + fr, col0 = u.pn * BM + wc * 32 + 8 * fq;
        const float* bp = bias + grp_of_pm(u.pm) * 8192 + col0;
        f32x4 bv[2][2];
#pragma unroll
        for (int bj = 0; bj < 2; ++bj)
#pragma unroll
            for (int n = 0; n < 2; ++n) bv[bj][n] = *(const f32x4*)(bp + bj * HALF + 4 * n);
#pragma unroll
        for (int ai = 0; ai < 2; ++ai)
#pragma unroll
            for (int m = 0; m < 4; ++m) { const int row = row0 + ai * HALF + m * 16; const float rs = row_rstd(ssq, row, fq);
#pragma unroll
                for (int bj = 0; bj < 2; ++bj) { f32x4 v0 = acc[ai][bj][m][0] * rs + bv[bj][0], v1 = acc[ai][bj][m][1] * rs + bv[bj][1];
#pragma unroll
                    for (int e = 0; e < 4; ++e) { const float a = fmaxf(v0[e], 0.f), b = fmaxf(v1[e], 0.f); v0[e] = a * a; v1[e] = b * b; }
                    *(u32x4*)(H + (size_t)row * 8192 + col0 + bj * HALF) = pk8(v0, v1); } }
    }
};
struct EpiB1 {
    static constexpr bool PERM = true, AFTER_DRAIN = false;
    const float* ssq; const float* bias; bf16_t* GY; bf16_t* UP;
    __device__ __forceinline__ void operator()(const f32x4 (&acc)[2][2][4][2], const Unit& u, int wr, int wc, int fr0, int fq0) const {
        int fr = fr0, fq = fq0; asm volatile("" : "+v"(fr), "+v"(fq));
        const int row0 = u.pm * BM + wr * 64 + fr, kind = u.pn >> 3, ct = (u.pn & 7) * BM + wc * 32 + 8 * fq, bcol = u.pn * BM + wc * 32 + 8 * fq;
        const float* bp = bias + grp_of_pm(u.pm) * 10240 + bcol;
        f32x4 bv[2][2];
#pragma unroll
        for (int bj = 0; bj < 2; ++bj)
#pragma unroll
            for (int n = 0; n < 2; ++n) bv[bj][n] = *(const f32x4*)(bp + bj * HALF + 4 * n);
#pragma unroll
        for (int ai = 0; ai < 2; ++ai)
#pragma unroll
            for (int m = 0; m < 4; ++m) { const int row = row0 + ai * HALF + m * 16; const float rs = row_rstd(ssq, row, fq);
#pragma unroll
                for (int bj = 0; bj < 2; ++bj) { f32x4 v0 = acc[ai][bj][m][0] * rs + bv[bj][0], v1 = acc[ai][bj][m][1] * rs + bv[bj][1];
                    const size_t off = (size_t)row * DM + ct + bj * HALF;
                    if (kind == 0) {
#pragma unroll
                        for (int e = 0; e < 4; ++e) { { const float y = v0[e]; v0[e] = y * sigmoidf_(1.5957691216f * (y + 0.044715f * y * y * y)); }
                                                      { const float y = v1[e]; v1[e] = y * sigmoidf_(1.5957691216f * (y + 0.044715f * y * y * y)); } }
                        *(u32x4*)(GY + off) = pk8(v0, v1); }
                    else *(u32x4*)(UP + off) = pk8(v0, v1); } }
    }
};
struct EpiGate {
    static constexpr bool PERM = true, AFTER_DRAIN = false;
    const float* gb; const float* cl; const bf16_t* U; bf16_t* LA; bf16_t* XI;
    __device__ __forceinline__ void operator()(const f32x4 (&acc)[2][2][4][2], const Unit& u, int wr, int wc, int fr0, int fq0) const {
        int fr = fr0, fq = fq0; asm volatile("" : "+v"(fr), "+v"(fq));
        const int row0 = u.pm * BM + wr * 64 + fr, d = u.pn >> 4, ch0 = (u.pn & 15) * HALF + wc * 32 + 8 * fq;
        f32x4 br[2], bi[2], cv[2];
#pragma unroll
        for (int n = 0; n < 2; ++n) { br[n] = *(const f32x4*)(gb + (d * 2 + 0) * DM + ch0 + 4 * n); bi[n] = *(const f32x4*)(gb + (d * 2 + 1) * DM + ch0 + 4 * n); cv[n] = *(const f32x4*)(cl + d * DM + ch0 + 4 * n); }
#pragma unroll
        for (int ai = 0; ai < 2; ++ai)
#pragma unroll
            for (int m = 0; m < 4; ++m) { const int row = row0 + ai * HALF + m * 16;
                const u32x4 uw = *(const u32x4*)(U + (size_t)row * DM + ch0);
                const float uf[8] = {bflo(uw.x), bfhi(uw.x), bflo(uw.y), bfhi(uw.y), bflo(uw.z), bfhi(uw.z), bflo(uw.w), bfhi(uw.w)};
                f32x4 la[2], xi[2];
#pragma unroll
                for (int n = 0; n < 2; ++n)
#pragma unroll
                    for (int e = 0; e < 4; ++e) { const float r = sigmoidf_(acc[ai][0][m][n][e] + br[n][e]), ig = sigmoidf_(acc[ai][1][m][n][e] + bi[n][e]);
                        const float l = cv[n][e] * r; la[n][e] = l; xi[n][e] = sqrtf(one_minus_exp(2.0f * l)) * ig * uf[4 * n + e]; }
                const size_t off = ((size_t)d * ROWS + row) * DM + ch0;
                *(u32x4*)(LA + off) = pk8(la[0], la[1]); *(u32x4*)(XI + off) = pk8(xi[0], xi[1]); asm volatile("" ::: "memory"); }
    }
};
struct GateOrder : StaticOrder { __device__ __forceinline__ int a_koff(const Unit& u) const { return ((u.pn & 15) >> 1) * 256; } };

template <class Epi, class Sched, bool ALIGN_EPI = false, bool SP2 = false>
__device__ __forceinline__ void gemm_phase(PG8_LAS unsigned char* lds, const Gemm g, const Sched& S, const Epi& E) {
    int tid = threadIdx.x; asm volatile("" : "+v"(tid));
    const int wid = __builtin_amdgcn_readfirstlane(tid >> 6), lane = tid & 63, wr = wid >> 2, wc = wid & 3, fr = lane & 15, fq = lane >> 4;
    int K = g.K, lda = g.lda; asm volatile("" : "+s"(K), "+s"(lda));
    const int nt = K / BK;
    unsigned voffA[2], voffB[2];
#pragma unroll
    for (int i = 0; i < 2; ++i) { int R, C; stage_rc(tid * 16 + i * 8192, R, C); const int Rb = Epi::PERM ? ((R & ~31) + perm32(R & 31)) : R;
        voffA[i] = (unsigned)(R * lda + C) * 2u; voffB[i] = (unsigned)(Rb * K + C) * 2u; }
    const size_t kstep = (size_t)(BK * 2);
    const size_t hstepA = (size_t)HALF * lda * 2, hstepB = (size_t)HALF * K * 2;
    const size_t tstepA = 2 * hstepA, tstepB = 2 * hstepB;
    const unsigned ldsw = (unsigned)wid * 1024u;
    const int aoff = lds_byte(wr * 64 + fr, fq * 8), boff = lds_byte(wc * 32 + fr, fq * 8);
#define PG8_SA(b, h) (((b) * 2 + (h)) * HTB)
#define PG8_SB(b, h) ((4 + (b) * 2 + (h)) * HTB)
#define PG8_STAGE(bufoff, gbase, voff) do { _Pragma("unroll") for (int _i = 0; _i < 2; ++_i) \
        __builtin_amdgcn_global_load_lds((const unsigned*)((const char*)(gbase) + (voff)[_i]), (PG8_LAS unsigned*)(lds + (bufoff) + ldsw + _i * 8192), 16, 0, 0); } while (0)
#define PG8_LDA(dst, b, h) do { _Pragma("unroll") for (int m = 0; m < 4; ++m) _Pragma("unroll") for (int k = 0; k < 2; ++k) dst[m][k] = *(const PG8_LAS bf16x8*)(lds + PG8_SA(b, h) + aoff + m * 2048 + k * 1024); } while (0)
#define PG8_LDB(dst, b, h) do { _Pragma("unroll") for (int n = 0; n < 2; ++n) _Pragma("unroll") for (int k = 0; k < 2; ++k) dst[n][k] = *(const PG8_LAS bf16x8*)(lds + PG8_SB(b, h) + boff + n * 2048 + k * 1024); } while (0)
#define PG8_MMA(ai, bj, At, Bt) do { __builtin_amdgcn_s_setprio(1); _Pragma("unroll") for (int m = 0; m < 4; ++m) _Pragma("unroll") for (int n = 0; n < 2; ++n) _Pragma("unroll") for (int k = 0; k < 2; ++k) \
        acc[ai][bj][m][n] = __builtin_amdgcn_mfma_f32_16x16x32_bf16(Bt[n][k], At[m][k], acc[ai][bj][m][n], 0, 0, 0); __builtin_amdgcn_s_setprio(0); } while (0)
#define PG8_WAIT_V(n) asm volatile("s_waitcnt vmcnt(" #n ")" ::: "memory")
#define PG8_WAIT_L(n) asm volatile("s_waitcnt lgkmcnt(" #n ")" ::: "memory")
#define PG8_BAR __builtin_amdgcn_s_barrier()
#define PG8_SCHED __builtin_amdgcn_sched_barrier(0)
    Unit cur, nxt; int ui = 0;
    if (!S.next(0, cur)) return;
    f32x4 acc[2][2][4][2];
#pragma unroll
    for (int a = 0; a < 2; ++a)
#pragma unroll
        for (int b = 0; b < 2; ++b)
#pragma unroll
            for (int m = 0; m < 4; ++m)
#pragma unroll
                for (int n = 0; n < 2; ++n) acc[a][b][m][n] = (f32x4){0.f, 0.f, 0.f, 0.f};
    bf16x8 At[4][2], B0[2][2], B1[2][2];
    const char* cA = (const char*)g.A + (size_t)cur.pm * tstepA + (size_t)S.a_koff(cur) * 2; const char* cB = (const char*)g.Bt + (size_t)cur.pn * tstepB;
    S.a_ready(cur);
    if constexpr (SP2) {
        PG8_STAGE(PG8_SB(0, 0), cB, voffB); PG8_STAGE(PG8_SB(0, 1), cB + hstepB, voffB); PG8_STAGE(PG8_SA(0, 0), cA, voffA); PG8_STAGE(PG8_SA(0, 1), cA + hstepA, voffA);
        if (wr == 1) PG8_BAR;
        PG8_WAIT_V(2); PG8_BAR;
        PG8_STAGE(PG8_SB(1, 0), cB + kstep, voffB); PG8_STAGE(PG8_SA(1, 0), cA + kstep, voffA); PG8_STAGE(PG8_SB(1, 1), cB + hstepB + kstep, voffB);
        PG8_WAIT_V(6); PG8_BAR;
    } else {
        PG8_STAGE(PG8_SB(0, 0), cB, voffB); PG8_STAGE(PG8_SA(0, 0), cA, voffA); PG8_STAGE(PG8_SB(0, 1), cB + hstepB, voffB); PG8_STAGE(PG8_SA(0, 1), cA + hstepA, voffA);
        if (wr == 1) PG8_BAR;
        PG8_WAIT_V(4); PG8_BAR;
        PG8_STAGE(PG8_SB(1, 0), cB + kstep, voffB); PG8_STAGE(PG8_SA(1, 0), cA + kstep, voffA); PG8_STAGE(PG8_SB(1, 1), cB + hstepB + kstep, voffB);
        PG8_WAIT_V(6); PG8_BAR;
    }
    for (;;) {
        const bool has_next = S.next(ui + 1, nxt);
        const char* nA = has_next ? (const char*)g.A + (size_t)nxt.pm * tstepA + (size_t)S.a_koff(nxt) * 2 : cA; const char* nB = has_next ? (const char*)g.Bt + (size_t)nxt.pn * tstepB : cB;
        for (int t = 0; t < nt; t += 2) {
            const bool last = (t == nt - 2);
            const char* a1 = cA + (size_t)(t + 1) * kstep;
            const char* a2 = last ? nA : cA + (size_t)(t + 2) * kstep; const char* b2 = last ? nB : cB + (size_t)(t + 2) * kstep;
            const char* a3 = a2 + kstep; const char* b3 = b2 + kstep;
            if (last && has_next) S.a_ready(nxt);
            if constexpr (SP2) {
            PG8_LDB(B0, 0, 0); PG8_LDB(B1, 0, 1); PG8_SCHED; PG8_LDA(At, 0, 0); PG8_STAGE(PG8_SA(1, 1), a1 + hstepA, voffA);
            PG8_WAIT_V(8); PG8_WAIT_L(0); PG8_BAR; PG8_MMA(0, 0, At, B0); PG8_MMA(0, 1, At, B1); PG8_BAR; PG8_SCHED;
            PG8_LDA(At, 0, 1); PG8_STAGE(PG8_SB(0, 0), b2, voffB); PG8_STAGE(PG8_SB(0, 1), b2 + hstepB, voffB); PG8_STAGE(PG8_SA(0, 0), a2, voffA);
            PG8_WAIT_V(8); PG8_WAIT_L(0); PG8_BAR; PG8_MMA(1, 0, At, B0); PG8_MMA(1, 1, At, B1); PG8_BAR; PG8_SCHED;
            PG8_LDB(B0, 1, 0); PG8_LDB(B1, 1, 1); PG8_SCHED; PG8_LDA(At, 1, 0); PG8_STAGE(PG8_SA(0, 1), a2 + hstepA, voffA);
            PG8_WAIT_V(8); PG8_WAIT_L(0); PG8_BAR; PG8_MMA(0, 0, At, B0); PG8_MMA(0, 1, At, B1); PG8_BAR; PG8_SCHED;
            PG8_LDA(At, 1, 1); PG8_STAGE(PG8_SB(1, 0), b3, voffB); PG8_STAGE(PG8_SB(1, 1), b3 + hstepB, voffB); PG8_STAGE(PG8_SA(1, 0), a3, voffA);
            PG8_WAIT_V(8); PG8_WAIT_L(0); PG8_BAR; PG8_MMA(1, 0, At, B0); PG8_MMA(1, 1, At, B1); PG8_BAR; PG8_SCHED;
            } else {
            PG8_LDB(B0, 0, 0); PG8_SCHED; PG8_LDA(At, 0, 0); PG8_STAGE(PG8_SA(1, 1), a1 + hstepA, voffA);
            PG8_WAIT_L(8); PG8_BAR; PG8_WAIT_L(0); PG8_MMA(0, 0, At, B0); PG8_BAR; PG8_SCHED;
            PG8_LDB(B1, 0, 1); PG8_STAGE(PG8_SB(0, 0), b2, voffB);
            PG8_BAR; PG8_WAIT_L(0); PG8_MMA(0, 1, At, B1); PG8_BAR;
            PG8_LDA(At, 0, 1); PG8_STAGE(PG8_SA(0, 0), a2, voffA);
            PG8_BAR; PG8_WAIT_L(0); PG8_MMA(1, 0, At, B0); PG8_BAR; PG8_SCHED;
            PG8_STAGE(PG8_SB(0, 1), b2 + hstepB, voffB);
            PG8_WAIT_V(6); PG8_BAR; PG8_MMA(1, 1, At, B1); PG8_BAR;
            PG8_LDB(B0, 1, 0); PG8_SCHED; PG8_LDA(At, 1, 0); PG8_STAGE(PG8_SA(0, 1), a2 + hstepA, voffA);
            PG8_WAIT_L(8); PG8_BAR; PG8_WAIT_L(0); PG8_MMA(0, 0, At, B0); PG8_BAR; PG8_SCHED;
            PG8_LDB(B1, 1, 1); PG8_STAGE(PG8_SB(1, 0), b3, voffB);
            PG8_BAR; PG8_WAIT_L(0); PG8_MMA(0, 1, At, B1); PG8_BAR;
            PG8_LDA(At, 1, 1); PG8_STAGE(PG8_SA(1, 0), a3, voffA);
            PG8_BAR; PG8_WAIT_L(0); PG8_MMA(1, 0, At, B0); PG8_BAR; PG8_SCHED;
            PG8_STAGE(PG8_SB(1, 1), b3 + hstepB, voffB);
            PG8_WAIT_V(6); PG8_BAR; PG8_MMA(1, 1, At, B1); PG8_BAR;
            }
        }
        if constexpr (ALIGN_EPI) { if (wr == 0) PG8_BAR; }
        if constexpr (!Epi::AFTER_DRAIN) { E(acc, cur, wr, wc, fr, fq); S.done(cur); }
        if (!has_next) break;
#pragma unroll
        for (int a = 0; a < 2; ++a)
#pragma unroll
            for (int b = 0; b < 2; ++b)
#pragma unroll
                for (int m = 0; m < 4; ++m)
#pragma unroll
                    for (int n = 0; n < 2; ++n) acc[a][b][m][n] = (f32x4){0.f, 0.f, 0.f, 0.f};
        cur = nxt; cA = nA; cB = nB; ++ui;
        if constexpr (ALIGN_EPI) { if (wr == 1) PG8_BAR; }
    }
    PG8_WAIT_V(0);
    if constexpr (!ALIGN_EPI) { if (wr == 0) PG8_BAR; }
    PG8_BAR;
    if constexpr (Epi::AFTER_DRAIN) { E.fused(acc, cur, wr, wc, fr, fq, lds, wid, lane); S.done(cur); }
#undef PG8_SA
#undef PG8_SB
#undef PG8_STAGE
#undef PG8_LDA
#undef PG8_LDB
#undef PG8_MMA
#undef PG8_WAIT_V
#undef PG8_WAIT_L
#undef PG8_BAR
#undef PG8_SCHED
}
}

#ifndef PG8_SP2
#define PG8_SP2 true
#endif
#ifndef PG8_ALIGN
#define PG8_ALIGN true
#endif
#ifndef MK_ONE_LAUNCH
#define MK_ONE_LAUNCH 0
#endif

constexpr int NWAVES = 8, NTHR = 512;
constexpr int D = 2048, NBATCH = 2, SEQ = 8192, CTXL = 256, DEPTH = 4, FF = 8192, TSEQ = SEQ + CTXL;
constexpr int M = NBATCH * TSEQ;
constexpr int NA_IN = 5 * D, NB_IN = 2 * D, NMOD = 6 * D;
constexpr int NSEG = TSEQ / 32;
constexpr float EPS = 1e-6f;
static_assert(M == pg8::ROWS && D == pg8::DM, "shapes");

constexpr size_t MiB = 1u << 20;
constexpr size_t WS_CTL = 0, CTL_ZERO_BYTES = 1 * MiB;
constexpr size_t WS_MOD = 1 * MiB;
constexpr size_t WS_BIAS1 = 2 * MiB;
constexpr size_t WS_BIAS2 = 3 * MiB;
constexpr size_t WS_LB = 4 * MiB;
constexpr size_t WS_CL = WS_LB + 65536, WS_GM = WS_LB + 131072;
constexpr size_t WS_SSQ = 5 * MiB;
constexpr size_t WS_CP = 8 * MiB, WS_CH = 17 * MiB, WS_CIN = 26 * MiB;
constexpr size_t WS_W = 64 * MiB;
constexpr size_t W_INA = 0, W_OUTA = W_INA + 2ull * NA_IN * D, W_INB = W_OUTA + 2ull * D * D, W_GATE = W_INB + 2ull * NB_IN * D, W_OUTB = W_GATE + 2ull * 32 * 256 * 256,
                 W_1 = W_OUTB + 2ull * D * D, W_2 = W_1 + 4ull * FF * D, W_END = W_2 + 4ull * FF * D;
static_assert(W_END * 2 <= 416 * MiB, "weights region");
constexpr size_t WS_X = 480 * MiB;
constexpr size_t WS_XM = 612 * MiB;
constexpr size_t WS_R0 = 678 * MiB, WS_R1 = 744 * MiB, WS_R2 = 810 * MiB, WS_R3 = 876 * MiB;
constexpr size_t WS_R4 = 942 * MiB;
constexpr size_t WS_R5 = 1206 * MiB;
constexpr size_t WS_END = 1338 * MiB;
constexpr int CW_BAR = 4096;

constexpr int RING_OFF = 0, RING_BYTES = 131072;
constexpr int LDSCTL_OFF = RING_BYTES, MISC_OFF = LDSCTL_OFF + 320;
constexpr int LDS_BYTES = 147456;

#define GAS __attribute__((address_space(1)))
#define LAS __attribute__((address_space(3)))
typedef unsigned short bf16;
typedef float f32x4 __attribute__((ext_vector_type(4)));
typedef float f32x2 __attribute__((ext_vector_type(2)));
typedef short bf16x8 __attribute__((ext_vector_type(8)));
typedef unsigned u32x4 __attribute__((ext_vector_type(4)));
typedef unsigned u32x2 __attribute__((ext_vector_type(2)));
using pg8::pk2; using pg8::pk8; using pg8::bflo; using pg8::bfhi;
#define LDS_WAIT() asm volatile("s_waitcnt lgkmcnt(0)" ::: "memory")

#define XB_TMO      128
#define XB_XCNT(j)  (256  + 64 * (j))
#define XB_XSUB(j)  (1280 + 64 * (j))
#define XB_XGEN(j)  (2304 + 64 * (j))
#define XB_TOP      3328
#define XB_TOPGEN   3392
#define XCD_BAR_WORDS 3456
#define XB_SPIN_CAP (1u << 18)
__device__ __forceinline__ unsigned xb_ld(unsigned* p)              { return __hip_atomic_load(p, __ATOMIC_RELAXED, __HIP_MEMORY_SCOPE_AGENT); }
__device__ __forceinline__ unsigned xb_add(unsigned* p, unsigned v) { return __hip_atomic_fetch_add(p, v, __ATOMIC_RELAXED, __HIP_MEMORY_SCOPE_AGENT); }
__device__ __forceinline__ unsigned xb_xcc_id() { return (unsigned)__builtin_amdgcn_s_getreg((3 << 11) | 20) & 0xFu; }
#define XB_SPIN(cond, bar) do { unsigned _sp = 0; while (cond) { __builtin_amdgcn_s_sleep(1); \
    if ((++_sp & 255u) == 0u) { if (xb_ld(&(bar)[XB_TMO])) break; if (_sp > XB_SPIN_CAP) { atomicAdd(&(bar)[XB_TMO], 1u); break; } } } } while (0)
struct XcdBarrier { unsigned* bar; unsigned x; volatile LAS unsigned* st; };
__device__ __forceinline__ XcdBarrier xcd_barrier_post(unsigned* bar, volatile LAS unsigned* st) {
    XcdBarrier b; b.bar = bar; b.x = xb_xcc_id(); b.st = st;
    if (threadIdx.x == 0) (void)xb_add(&bar[XB_XCNT(b.x)], 1u);
    return b;
}
__device__ __forceinline__ void xcd_barrier_complete(unsigned* bar, unsigned x, unsigned& nloc, unsigned& nx) {
    const unsigned G = gridDim.x * gridDim.y * gridDim.z;
    unsigned sum, cnt, mine, sp = 0u;
    for (;;) {
        sum = 0u; cnt = 0u; mine = 0u;
#pragma unroll
        for (unsigned j = 0; j < 16; ++j) { const unsigned c = xb_ld(&bar[XB_XCNT(j)]); sum += c; cnt += (c > 0u) ? 1u : 0u; mine = (j == x) ? c : mine; }
        if (sum == G) break;
        __builtin_amdgcn_s_sleep(1);
        if ((++sp & 255u) == 0u) { if (xb_ld(&bar[XB_TMO])) break; if (sp > XB_SPIN_CAP) { atomicAdd(&bar[XB_TMO], 1u); break; } }
    }
    nloc = mine > 0u ? mine : 1u; nx = cnt > 0u ? cnt : 1u;
}
__device__ __forceinline__ void xcd_barrier(const XcdBarrier& b) {
    asm volatile("s_waitcnt vmcnt(0)" ::: "memory");
    __syncthreads();
    if (threadIdx.x == 0) {
        unsigned* bar = b.bar;
        __builtin_amdgcn_s_waitcnt(0);
        unsigned nloc = b.st[0], nx = b.st[1];
        if (nloc == 0u) { xcd_barrier_complete(bar, b.x, nloc, nx); b.st[0] = nloc; b.st[1] = nx; }
        const unsigned old = xb_add(&bar[XB_XSUB(b.x)], 1u);
        const unsigned gen = old / nloc;
        if (old + 1u == (gen + 1u) * nloc) {
            __builtin_amdgcn_fence(__ATOMIC_RELEASE, "agent");
            asm volatile("s_waitcnt vmcnt(0)" ::: "memory");
            const unsigned og = xb_add(&bar[XB_TOP], 1u);
            const unsigned tg = og / nx;
            if (og + 1u == (tg + 1u) * nx) xb_add(&bar[XB_TOPGEN], 1u);
            else XB_SPIN(xb_ld(&bar[XB_TOPGEN]) == tg, bar);
            __builtin_amdgcn_fence(__ATOMIC_ACQUIRE, "agent");
            xb_add(&bar[XB_XGEN(b.x)], 1u);
            asm volatile("s_waitcnt vmcnt(0)" ::: "memory");
        } else {
            XB_SPIN(xb_ld(&bar[XB_XGEN(b.x)]) == gen, bar);
            __builtin_amdgcn_fence(__ATOMIC_ACQUIRE, "agent");
            asm volatile("s_waitcnt vmcnt(0)" ::: "memory");
        }
    }
    __syncthreads();
}

__device__ __forceinline__ float wave_sum(float v) {
#pragma unroll
    for (int o = 1; o < 64; o <<= 1) v += __shfl_xor(v, o);
    return v;
}
__device__ __forceinline__ int row_of(int b, int tau) { return tau < CTXL ? b * CTXL + tau : 2 * CTXL + b * SEQ + (tau - CTXL); }
__device__ __forceinline__ float siluf_(float v) { return v / (1.0f + __expf(-v)); }

template <class RowMap>
__device__ __forceinline__ void transpose_item(const float* W, int K, int N, bf16* WT, const RowMap& rm, LAS float* scr, int item, int lane) {
    const int nblk = N / 32, kb = item / nblk, nb = item % nblk, k0 = 64 * kb, n0 = 32 * nb;
#pragma unroll 8
    for (int i = 0; i < 32; ++i) { const int kk = 2 * i + (lane >> 5); scr[kk * 33 + (lane & 31)] = W[(size_t)(k0 + kk) * N + n0 + (lane & 31)]; }
    LDS_WAIT(); asm volatile("" ::: "memory");
    const int c = lane & 7;
#pragma unroll
    for (int j = 0; j < 4; ++j) { const int n = (lane >> 3) + 8 * j; const LAS float* s = scr + (8 * c) * 33 + n;
        u32x4 o; o.x = pk2(s[0 * 33], s[1 * 33]); o.y = pk2(s[2 * 33], s[3 * 33]); o.z = pk2(s[4 * 33], s[5 * 33]); o.w = pk2(s[6 * 33], s[7 * 33]);
        *(GAS u32x4*)(WT + (size_t)rm(n0 + n) * K + k0 + 8 * c) = o; }
    LDS_WAIT(); asm volatile("" ::: "memory");
}
struct RowId { __device__ __forceinline__ int operator()(int n) const { return n; } };
struct RowGate { int d, gi, nblk; __device__ __forceinline__ int operator()(int c) const { return (d * 16 + 2 * nblk + (c >> 7)) * 256 + gi * 128 + (c & 127); } };

__device__ __forceinline__ void p0_mod(LAS unsigned char* lds, const float* c, const float* c_ctx, const float* w_mod, const float* b_mod, float* MOD, int G, int tid) {
    LAS float* sil = (LAS float*)(lds + 81920);
    LAS float* red = (LAS float*)(lds + 106496);
    const int lane = tid & 63, w = tid >> 6;
    bool have = false;
    for (int it = blockIdx.x; it < 192; it += G) {
        if (!have) { for (int i = tid; i < 3 * D; i += NTHR) { const int g = i / D, k = i % D; const float v = g == 0 ? c_ctx[k] : c[(g - 1) * D + k]; sil[i] = siluf_(v); } __syncthreads(); have = true; }
        const int l = it / 48, cb = it % 48, n0 = cb * 256 + lane * 4;
        f32x4 a0 = {0.f, 0.f, 0.f, 0.f}, a1 = a0, a2 = a0;
        const float* wp = w_mod + ((size_t)l * D + w * 256) * NMOD + n0;
#pragma unroll 8
        for (int k = 0; k < 256; ++k) { const f32x4 wv = *(const f32x4*)(wp + (size_t)k * NMOD); const int kk = w * 256 + k; a0 += sil[kk] * wv; a1 += sil[D + kk] * wv; a2 += sil[2 * D + kk] * wv; }
        *(LAS f32x4*)(red + (w * 3 + 0) * 256 + lane * 4) = a0; *(LAS f32x4*)(red + (w * 3 + 1) * 256 + lane * 4) = a1; *(LAS f32x4*)(red + (w * 3 + 2) * 256 + lane * 4) = a2;
        __syncthreads();
        for (int i = tid; i < 768; i += NTHR) { const int g = i >> 8, col = i & 255; float s = 0.f;
#pragma unroll
            for (int w2 = 0; w2 < 8; ++w2) s += red[(w2 * 3 + g) * 256 + col];
            const int n = cb * 256 + col; MOD[(size_t)(l * 3 + g) * NMOD + n] = s + b_mod[(size_t)l * NMOD + n]; }
        __syncthreads();
    }
}
struct RowGen { int mode, d, gi, nblk; __device__ __forceinline__ int operator()(int n) const { return mode ? (d * 16 + 2 * nblk + (n >> 7)) * 256 + gi * 128 + (n & 127) : n; } };
__device__ __forceinline__ void p0_weights(LAS unsigned char* lds, const float* a_w_in, const float* a_w_out, const float* b_w_in, const float* b_gate_w, const float* b_w_out, const float* mlp_w1, const float* mlp_w2,
                                           bf16* Wb, int gw, int NGW, int lane, int wave) {
    LAS float* scr = (LAS float*)(lds + wave * 8448);
    constexpr int I_INA = (D / 64) * (NA_IN / 32), I_DD = (D / 64) * (D / 32), I_INB = (D / 64) * (NB_IN / 32), I_G = 4 * 8, I_1 = (D / 64) * (FF / 32), I_2 = (FF / 64) * (D / 32);
    constexpr int NITEMS = 2 * I_INA + 2 * I_DD + 2 * I_INB + 64 * I_G + 2 * I_DD + 4 * I_1 + 4 * I_2;
    for (int it = gw; it < NITEMS; it += NGW) {
        int r = it; const float* src; bf16* dst; int K, N, item; RowGen rm{0, 0, 0, 0};
        if (r < 2 * I_INA) { const int j = r / I_INA; item = r % I_INA; src = a_w_in + (size_t)j * D * NA_IN; dst = Wb + W_INA + (size_t)j * NA_IN * D; K = D; N = NA_IN; }
        else if ((r -= 2 * I_INA) < 2 * I_DD) { const int j = r / I_DD; item = r % I_DD; src = a_w_out + (size_t)j * D * D; dst = Wb + W_OUTA + (size_t)j * D * D; K = D; N = D; }
        else if ((r -= 2 * I_DD) < 2 * I_INB) { const int j = r / I_INB; item = r % I_INB; src = b_w_in + (size_t)j * D * NB_IN; dst = Wb + W_INB + (size_t)j * NB_IN * D; K = D; N = NB_IN; }
        else if ((r -= 2 * I_INB) < 64 * I_G) { const int mi = r / I_G; item = r % I_G; src = b_gate_w + (size_t)mi * 65536; const int j = mi >> 5; dst = Wb + W_GATE + (size_t)j * 32 * 65536; K = 256; N = 256;
            rm.mode = 1; rm.d = (mi >> 4) & 1; rm.gi = (mi >> 3) & 1; rm.nblk = mi & 7; }
        else if ((r -= 64 * I_G) < 2 * I_DD) { const int j = r / I_DD; item = r % I_DD; src = b_w_out + (size_t)j * D * D; dst = Wb + W_OUTB + (size_t)j * D * D; K = D; N = D; }
        else if ((r -= 2 * I_DD) < 4 * I_1) { const int l = r / I_1; item = r % I_1; src = mlp_w1 + (size_t)l * D * FF; dst = Wb + W_1 + (size_t)l * FF * D; K = D; N = FF; }
        else { r -= 4 * I_1; const int l = r / I_2; item = r % I_2; src = mlp_w2 + (size_t)l * FF * D; dst = Wb + W_2 + (size_t)l * D * FF; K = FF; N = D; }
        transpose_item(src, K, N, dst, rm, scr, item, lane);
    }
}
__device__ __forceinline__ void p0_tables(const float* a_lb, const float* b_lambda, float* LB, float* CL, int gt, int NGT) {
    for (int i = gt; i < 2 * D; i += NGT) { const float l0 = a_lb[i], l1 = a_lb[2 * D + i], mx = fmaxf(l0, l1), e0 = expf(l0 - mx), e1 = expf(l1 - mx); LB[i] = 0.f; LB[2 * D + i] = e1 / (e0 + e1); }
    for (int i = gt; i < 4 * D; i += NGT) CL[i] = -8.0f * log1pf(expf(-b_lambda[i]));
}

__device__ __forceinline__ void p1_phase(const float* xin, const float* ctx, const float* norm1, const float* norm2, const float* MOD, float* GM, float* X, bf16* XM, float* SSQ,
                                         const bf16* Wb, float* BIAS1, float* BIAS2, int gw, int NGW, int gt, int NGT, int lane) {
    for (int i = gt; i < DEPTH * 2 * 3 * D; i += NGT) { const int k = i % D, g = (i / D) % 3, wh = (i / (3 * D)) & 1, l = i / (6 * D);
        GM[i] = (wh ? norm2 : norm1)[l * D + k] * (1.0f + MOD[(size_t)(l * 3 + g) * NMOD + (wh ? 4 : 1) * D + k]); }
    for (int row = gw; row < M; row += NGW) {
        const float* src = row < 2 * CTXL ? ctx + (size_t)row * D : xin + (size_t)(row - 2 * CTXL) * D;
        const int g = row < 2 * CTXL ? 0 : (row < 2 * CTXL + SEQ ? 1 : 2);
        f32x4 v[8]; float ss = 0.f;
#pragma unroll
        for (int j = 0; j < 8; ++j) { v[j] = *(const f32x4*)(src + lane * 4 + 256 * j); ss += (v[j][0] * v[j][0] + v[j][1] * v[j][1]) + (v[j][2] * v[j][2] + v[j][3] * v[j][3]); }
        ss = wave_sum(ss);
#pragma unroll
        for (int j = 0; j < 8; ++j) { const int k = lane * 4 + 256 * j; *(f32x4*)(X + (size_t)row * D + k) = v[j];
            const f32x4 gm = *(const f32x4*)(norm1 + k) * (1.0f + *(const f32x4*)(MOD + (size_t)g * NMOD + D + k)); const f32x4 y = v[j] * gm;
            u32x2 o; o.x = pk2(y[0], y[1]); o.y = pk2(y[2], y[3]); *(u32x2*)(XM + (size_t)row * D + k) = o; }
        if (lane < 32) SSQ[(size_t)row * 32 + lane] = lane == 0 ? ss : 0.f;
    }
    for (int r = gw; r < 2 * NA_IN + 2 * NB_IN + 4 * FF; r += NGW) {
        const bf16* wrow; const float* sh; float* out; int ostride;
        if (r < 2 * NA_IN) { const int j = r / NA_IN, n = r % NA_IN, l = 2 * j; wrow = Wb + W_INA + ((size_t)j * NA_IN + n) * D; sh = MOD + (size_t)l * 3 * NMOD; out = BIAS1 + (size_t)l * 3 * 10240 + n; ostride = 10240; }
        else if (r < 2 * NA_IN + 2 * NB_IN) { const int r2 = r - 2 * NA_IN, j = r2 / NB_IN, n = r2 % NB_IN, l = 2 * j + 1; wrow = Wb + W_INB + ((size_t)j * NB_IN + n) * D; sh = MOD + (size_t)l * 3 * NMOD; out = BIAS1 + (size_t)l * 3 * 10240 + n; ostride = 10240; }
        else { const int r2 = r - 2 * NA_IN - 2 * NB_IN, l = r2 / FF, n = r2 % FF; wrow = Wb + W_1 + ((size_t)l * FF + n) * D; sh = MOD + (size_t)l * 3 * NMOD + 3 * D; out = BIAS2 + (size_t)l * 3 * FF + n; ostride = FF; }
        float s0 = 0.f, s1 = 0.f, s2 = 0.f;
#pragma unroll
        for (int j = 0; j < 4; ++j) { const int k = lane * 8 + 512 * j; const u32x4 ww = *(const u32x4*)(wrow + k);
            const float wf[8] = {bflo(ww.x), bfhi(ww.x), bflo(ww.y), bfhi(ww.y), bflo(ww.z), bfhi(ww.z), bflo(ww.w), bfhi(ww.w)};
#pragma unroll
            for (int e = 0; e < 8; ++e) { s0 += wf[e] * sh[k + e]; s1 += wf[e] * sh[NMOD + k + e]; s2 += wf[e] * sh[2 * NMOD + k + e]; } }
        s0 = wave_sum(s0); s1 = wave_sum(s1); s2 = wave_sum(s2);
        if (lane == 0) { out[0] = s0; out[ostride] = s1; out[2 * ostride] = s2; }
    }
}

constexpr int H3_QT = 0, H3_KT = 8704, H3_KH = 17408, H3_VT = 27648, H3_DEC = 37888, H3_BUF = 38400;
static_assert(2 * H3_BUF <= RING_BYTES, "H3 LDS");
__device__ __forceinline__ bf16x8 frag16(const LAS unsigned char* p) { return *(const LAS bf16x8*)p; }
__device__ __forceinline__ bf16x8 frag8x2(const LAS unsigned char* p0, const LAS unsigned char* p1) { const u32x2 a = *(const LAS u32x2*)p0, b = *(const LAS u32x2*)p1; const u32x4 w = {a.x, a.y, b.x, b.y}; return __builtin_bit_cast(bf16x8, w); }
#define MFMA16(a, b, c) __builtin_amdgcn_mfma_f32_16x16x32_bf16((a), (b), (c), 0, 0, 0)
__device__ __forceinline__ void hgrn_scan_phase(LAS unsigned char* lds, const bf16* Q, const bf16* V, const float* LF, bf16* O, int G, int tid) {
    const int lane = tid & 63, w = __builtin_amdgcn_readfirstlane(tid >> 6);
    const int c = lane & 15, q4 = lane >> 4, dq = lane & 3, tp = lane >> 2, vi = tid >> 4, vd8 = (tid & 15) * 8, dv0 = 16 * w;
    constexpr int NCH = TSEQ / 32;
    for (int item = blockIdx.x; item < 64; item += G) {
        const int b = item >> 5, dir = (item >> 4) & 1, h = item & 15, sgn = dir ? -1 : 1, hoff = h * 128;
        const float* LFd = LF + (size_t)dir * M * D; bf16* Od = O + (size_t)dir * M * D;
        f32x4 St[8];
#pragma unroll
        for (int t = 0; t < 8; ++t) St[t] = (f32x4){0.f, 0.f, 0.f, 0.f};
        f32x4 lf0A, lf1A, lf0B, lf1B; u32x2 qq0A, qq1A, qq0B, qq1B; u32x4 vvA, vvB;
#define H3_RBASE(cc) ((32 * (cc) < CTXL) ? (b * CTXL + (dir ? CTXL - 1 - 32 * (cc) : 32 * (cc))) : (2 * CTXL + b * SEQ + (dir ? SEQ - 1 - (32 * (cc) - CTXL) : (32 * (cc) - CTXL))))
#define H3_LOAD(S, cc) do { const int rb_ = H3_RBASE(cc); const int r0_ = rb_ + sgn * (2 * tp), r1_ = r0_ + sgn; const int co_ = hoff + 16 * w + 4 * dq; \
            lf0##S = *(const f32x4*)(LFd + (size_t)r0_ * D + co_); lf1##S = *(const f32x4*)(LFd + (size_t)r1_ * D + co_); \
            qq0##S = *(const u32x2*)(Q + (size_t)r0_ * D + co_); qq1##S = *(const u32x2*)(Q + (size_t)r1_ * D + co_); \
            vv##S = *(const u32x4*)(V + (size_t)(rb_ + sgn * vi) * D + hoff + vd8); } while (0)
#define H3_PREP(S, bo) do { LAS unsigned char* B_ = lds + (bo); f32x4 x_ = lf0##S + lf1##S; \
            _Pragma("unroll") for (int off_ = 4; off_ < 64; off_ <<= 1) { f32x4 y_; _Pragma("unroll") for (int e = 0; e < 4; ++e) y_[e] = __shfl_up(x_[e], off_); if (lane >= off_) x_ += y_; } \
            f32x4 bC_, eC_; _Pragma("unroll") for (int e = 0; e < 4; ++e) { bC_[e] = __shfl(x_[e], 60 + dq); eC_[e] = __expf(bC_[e]); } \
            const f32x4 b1_ = x_, b0_ = x_ - lf1##S; \
            const float qf0_[4] = {bflo(qq0##S.x), bfhi(qq0##S.x), bflo(qq0##S.y), bfhi(qq0##S.y)}, qf1_[4] = {bflo(qq1##S.x), bfhi(qq1##S.x), bflo(qq1##S.y), bfhi(qq1##S.y)}; \
            f32x4 qt0_, kt0_, kh0_, qt1_, kt1_, kh1_; \
            _Pragma("unroll") for (int e = 0; e < 4; ++e) { \
                { const float k_ = 1.0f - __expf(lf0##S[e]); qt0_[e] = qf0_[e] * __expf(b0_[e]); kt0_[e] = k_ * __expf(-b0_[e]); kh0_[e] = kt0_[e] * eC_[e]; } \
                { const float k_ = 1.0f - __expf(lf1##S[e]); qt1_[e] = qf1_[e] * __expf(b1_[e]); kt1_[e] = k_ * __expf(-b1_[e]); kh1_[e] = kt1_[e] * eC_[e]; } } \
            const int dko_ = 16 * w + 4 * dq; \
            { u32x2 o_; o_.x = pk2(qt0_[0], qt0_[1]); o_.y = pk2(qt0_[2], qt0_[3]); *(LAS u32x2*)(B_ + H3_QT + (2 * tp) * 272 + dko_ * 2) = o_; } \
            { u32x2 o_; o_.x = pk2(qt1_[0], qt1_[1]); o_.y = pk2(qt1_[2], qt1_[3]); *(LAS u32x2*)(B_ + H3_QT + (2 * tp + 1) * 272 + dko_ * 2) = o_; } \
            { u32x2 o_; o_.x = pk2(kt0_[0], kt0_[1]); o_.y = pk2(kt0_[2], kt0_[3]); *(LAS u32x2*)(B_ + H3_KT + (2 * tp) * 272 + dko_ * 2) = o_; } \
            { u32x2 o_; o_.x = pk2(kt1_[0], kt1_[1]); o_.y = pk2(kt1_[2], kt1_[3]); *(LAS u32x2*)(B_ + H3_KT + (2 * tp + 1) * 272 + dko_ * 2) = o_; } \
            _Pragma("unroll") for (int e = 0; e < 4; ++e) *(LAS unsigned*)(B_ + H3_KH + (dko_ + e) * 80 + (2 * tp) * 2) = pk2(kh0_[e], kh1_[e]); \
            if (tp == 15) *(LAS f32x4*)(B_ + H3_DEC + dko_ * 4) = eC_; \
            { const unsigned vw_[4] = {vv##S.x, vv##S.y, vv##S.z, vv##S.w}; \
              _Pragma("unroll") for (int e = 0; e < 4; ++e) { *(LAS unsigned short*)(B_ + H3_VT + (vd8 + 2 * e) * 80 + vi * 2) = (unsigned short)(vw_[e] & 0xffffu); \
                                                             *(LAS unsigned short*)(B_ + H3_VT + (vd8 + 2 * e + 1) * 80 + vi * 2) = (unsigned short)(vw_[e] >> 16); } } \
        } while (0)
#define H3_MMA(bo, cc) do { const LAS unsigned char* B_ = lds + (bo); \
            f32x4 X00 = {0.f, 0.f, 0.f, 0.f}, X01 = X00, X11 = X00; \
            _Pragma("unroll") for (int ks = 0; ks < 4; ++ks) { const int ko_ = (32 * ks + 8 * q4) * 2; \
                const bf16x8 a0_ = frag16(B_ + H3_KT + c * 272 + ko_), a1_ = frag16(B_ + H3_KT + (16 + c) * 272 + ko_), b0_ = frag16(B_ + H3_QT + c * 272 + ko_), b1_ = frag16(B_ + H3_QT + (16 + c) * 272 + ko_); \
                X00 = MFMA16(a0_, b0_, X00); X01 = MFMA16(a0_, b1_, X01); X11 = MFMA16(a1_, b1_, X11); } \
            _Pragma("unroll") for (int r_ = 0; r_ < 4; ++r_) if (4 * q4 + r_ > c) { X00[r_] = 0.f; X11[r_] = 0.f; } \
            const bf16x8 va_ = frag8x2(B_ + H3_VT + (dv0 + c) * 80 + 8 * q4, B_ + H3_VT + (dv0 + c) * 80 + 32 + 8 * q4); \
            const u32x4 xw0_ = {pk2(X00[0], X00[1]), pk2(X00[2], X00[3]), 0u, 0u}, xw1_ = {pk2(X01[0], X01[1]), pk2(X01[2], X01[3]), pk2(X11[0], X11[1]), pk2(X11[2], X11[3])}; \
            f32x4 OT0 = {0.f, 0.f, 0.f, 0.f}, OT1 = OT0; \
            OT0 = MFMA16(va_, __builtin_bit_cast(bf16x8, xw0_), OT0); OT1 = MFMA16(va_, __builtin_bit_cast(bf16x8, xw1_), OT1); \
            _Pragma("unroll") for (int ks = 0; ks < 4; ++ks) { const u32x4 sw_ = pk8(St[2 * ks], St[2 * ks + 1]); const bf16x8 sa_ = __builtin_bit_cast(bf16x8, sw_); \
                const int k0_ = (32 * ks + 4 * q4) * 2, k1_ = (32 * ks + 16 + 4 * q4) * 2; \
                const bf16x8 qb0_ = frag8x2(B_ + H3_QT + c * 272 + k0_, B_ + H3_QT + c * 272 + k1_), qb1_ = frag8x2(B_ + H3_QT + (16 + c) * 272 + k0_, B_ + H3_QT + (16 + c) * 272 + k1_); \
                OT0 = MFMA16(sa_, qb0_, OT0); OT1 = MFMA16(sa_, qb1_, OT1); } \
            { const int rb_ = H3_RBASE(cc); u32x2 o0_, o1_; o0_.x = pk2(OT0[0], OT0[1]); o0_.y = pk2(OT0[2], OT0[3]); o1_.x = pk2(OT1[0], OT1[1]); o1_.y = pk2(OT1[2], OT1[3]); \
              *(u32x2*)(Od + (size_t)(rb_ + sgn * c) * D + hoff + dv0 + 4 * q4) = o0_; *(u32x2*)(Od + (size_t)(rb_ + sgn * (16 + c)) * D + hoff + dv0 + 4 * q4) = o1_; } \
            const bf16x8 vb_ = frag16(B_ + H3_VT + (dv0 + c) * 80 + 16 * q4); \
            _Pragma("unroll") for (int t = 0; t < 8; ++t) { const bf16x8 ka_ = frag16(B_ + H3_KH + (16 * t + c) * 80 + 16 * q4); const f32x4 dec_ = *(const LAS f32x4*)(B_ + H3_DEC + (16 * t + 4 * q4) * 4); \
                St[t] = MFMA16(ka_, vb_, St[t] * dec_); } \
        } while (0)
        H3_LOAD(A, 0); H3_LOAD(B, 1);
        H3_PREP(A, 0); H3_LOAD(A, 2);
        __syncthreads();
        for (int cc = 0; cc < NCH; cc += 2) {
            if (cc + 1 < NCH) { H3_PREP(B, H3_BUF); if (cc + 3 < NCH) H3_LOAD(B, cc + 3); }
            H3_MMA(0, cc);
            __syncthreads();
            if (cc + 2 < NCH) { H3_PREP(A, 0); if (cc + 4 < NCH) H3_LOAD(A, cc + 4); }
            if (cc + 1 < NCH) H3_MMA(H3_BUF, cc + 1);
            __syncthreads();
        }
#undef H3_LOAD
#undef H3_PREP
#undef H3_MMA
#undef H3_RBASE
    }
}

__device__ __forceinline__ void a3_phase(const bf16* O, const bf16* SG, const float* onorm, bf16* OG, int gw, int NGW, int lane) {
    for (int it = gw; it < M * 4; it += NGW) { const int row = it >> 2, c8 = (it & 3) * 512 + lane * 8;
        const u32x4 a = *(const u32x4*)(O + (size_t)row * D + c8), b = *(const u32x4*)(O + ((size_t)M + row) * D + c8), s = *(const u32x4*)(SG + (size_t)row * D + c8);
        const f32x4 n0 = *(const f32x4*)(onorm + c8), n1 = *(const f32x4*)(onorm + c8 + 4);
        float o[8] = {bflo(a.x) + bflo(b.x), bfhi(a.x) + bfhi(b.x), bflo(a.y) + bflo(b.y), bfhi(a.y) + bfhi(b.y), bflo(a.z) + bflo(b.z), bfhi(a.z) + bfhi(b.z), bflo(a.w) + bflo(b.w), bfhi(a.w) + bfhi(b.w)};
        const float sg[8] = {bflo(s.x), bfhi(s.x), bflo(s.y), bfhi(s.y), bflo(s.z), bfhi(s.z), bflo(s.w), bfhi(s.w)};
        float ss = 0.f;
#pragma unroll
        for (int e = 0; e < 8; ++e) ss += o[e] * o[e];
        ss += __shfl_xor(ss, 1); ss += __shfl_xor(ss, 2); ss += __shfl_xor(ss, 4); ss += __shfl_xor(ss, 8);
        const float r = 1.0f / sqrtf(ss * (1.0f / 128.0f) + EPS);
#pragma unroll
        for (int e = 0; e < 8; ++e) o[e] = o[e] * r * (e < 4 ? n0[e & 3] : n1[e & 3]) * sg[e];
        u32x4 y; y.x = pk2(o[0], o[1]); y.y = pk2(o[2], o[3]); y.z = pk2(o[4], o[5]); y.w = pk2(o[6], o[7]);
        *(u32x4*)(OG + (size_t)row * D + c8) = y; }
}
__device__ __forceinline__ void conv_phase(const bf16* UP, const float* cw, const float* cb, bf16* U, int gt, int NGT) {
    for (int idx = gt; idx < M * 256; idx += NGT) { const int row = idx >> 8, c8 = (idx & 255) * 8;
        int lo, hi; if (row < 2 * CTXL) { lo = (row / CTXL) * CTXL; hi = lo + CTXL; } else { lo = 2 * CTXL + ((row - 2 * CTXL) / SEQ) * SEQ; hi = lo + SEQ; }
        f32x4 a0 = *(const f32x4*)(cb + c8), a1 = *(const f32x4*)(cb + c8 + 4);
#pragma unroll
        for (int j = 0; j < 4; ++j) { const int rr = row + j - 2;
            if (rr >= lo && rr < hi) { const u32x4 uw = *(const u32x4*)(UP + (size_t)rr * D + c8); const f32x4 w0 = *(const f32x4*)(cw + j * D + c8), w1 = *(const f32x4*)(cw + j * D + c8 + 4);
                a0 += w0 * (f32x4){bflo(uw.x), bfhi(uw.x), bflo(uw.y), bfhi(uw.y)}; a1 += w1 * (f32x4){bflo(uw.z), bfhi(uw.z), bflo(uw.w), bfhi(uw.w)}; } }
        *(u32x4*)(U + (size_t)row * D + c8) = pk8(a0, a1); }
}
__device__ __forceinline__ void r1_phase(const bf16* LA, const bf16* XI, float* CP, float* CH, int gt, int NGT) {
    for (int it = gt; it < 2 * 2 * NSEG * 256; it += NGT) { const int c8 = (it & 255) * 8; int r = it >> 8; const int s = r % NSEG; r /= NSEG; const int dir = r & 1, b = r >> 1;
        const bf16* la = LA + (size_t)dir * M * D + c8; const bf16* xi = XI + (size_t)dir * M * D + c8; const int rb = row_of(b, 32 * s);
        float P[8], H[8];
#pragma unroll
        for (int e = 0; e < 8; ++e) { P[e] = 0.f; H[e] = 0.f; }
#pragma unroll 4
        for (int i = 0; i < 32; ++i) { const int row = rb + (dir ? 31 - i : i); const u32x4 lw = *(const u32x4*)(la + (size_t)row * D), xw = *(const u32x4*)(xi + (size_t)row * D);
            const float l[8] = {bflo(lw.x), bfhi(lw.x), bflo(lw.y), bfhi(lw.y), bflo(lw.z), bfhi(lw.z), bflo(lw.w), bfhi(lw.w)}, x[8] = {bflo(xw.x), bfhi(xw.x), bflo(xw.y), bfhi(xw.y), bflo(xw.z), bfhi(xw.z), bflo(xw.w), bfhi(xw.w)};
#pragma unroll
            for (int e = 0; e < 8; ++e) { P[e] += l[e]; H[e] = __expf(l[e]) * H[e] + x[e]; } }
        const size_t o = ((size_t)(b * 2 + dir) * NSEG + s) * D + c8;
        *(f32x4*)(CP + o) = (f32x4){P[0], P[1], P[2], P[3]}; *(f32x4*)(CP + o + 4) = (f32x4){P[4], P[5], P[6], P[7]};
        *(f32x4*)(CH + o) = (f32x4){H[0], H[1], H[2], H[3]}; *(f32x4*)(CH + o + 4) = (f32x4){H[4], H[5], H[6], H[7]}; }
}
__device__ __forceinline__ void r2_phase(const float* CP, const float* CH, float* CIN, int gt, int NGT) {
    for (int it = gt; it < 2 * 2 * D; it += NGT) { const int ch = it & (D - 1), dir = (it >> 11) & 1, b = it >> 12; const size_t base = (size_t)(b * 2 + dir) * NSEG * D + ch; float h = 0.f;
#pragma unroll 8
        for (int i = 0; i < NSEG; ++i) { const int s = dir ? (i < 8 ? 7 - i : NSEG + 7 - i) : i; const size_t o = base + (size_t)s * D; CIN[o] = h; h = __expf(CP[o]) * h + CH[o]; } }
}
__device__ __forceinline__ void r3_phase(const bf16* LA, const bf16* XI, const bf16* GY, const float* CIN, bf16* HG, int G, int tid) {
    for (int it = blockIdx.x; it < 2 * NSEG; it += G) { const int b = it / NSEG, s = it % NSEG, c4 = tid * 4, rb = row_of(b, 32 * s);
        f32x4 hf[32]; f32x4 h = *(const f32x4*)(CIN + ((size_t)(b * 2 + 0) * NSEG + s) * D + c4);
#pragma unroll
        for (int i = 0; i < 32; ++i) { const size_t o = (size_t)(rb + i) * D + c4; const u32x2 lw = *(const u32x2*)(LA + o), xw = *(const u32x2*)(XI + o);
            const f32x4 l = {bflo(lw.x), bfhi(lw.x), bflo(lw.y), bfhi(lw.y)}, x = {bflo(xw.x), bfhi(xw.x), bflo(xw.y), bfhi(xw.y)};
#pragma unroll
            for (int e = 0; e < 4; ++e) h[e] = __expf(l[e]) * h[e] + x[e];
            hf[i] = h; if ((i & 7) == 7) asm volatile("" ::: "memory"); }
        h = *(const f32x4*)(CIN + ((size_t)(b * 2 + 1) * NSEG + s) * D + c4);
#pragma unroll
        for (int i = 31; i >= 0; --i) { const size_t o = (size_t)(rb + i) * D + c4; const u32x2 lw = *(const u32x2*)(LA + (size_t)M * D + o), xw = *(const u32x2*)(XI + (size_t)M * D + o), gw2 = *(const u32x2*)(GY + o);
            const f32x4 l = {bflo(lw.x), bfhi(lw.x), bflo(lw.y), bfhi(lw.y)}, x = {bflo(xw.x), bfhi(xw.x), bflo(xw.y), bfhi(xw.y)}, g = {bflo(gw2.x), bfhi(gw2.x), bflo(gw2.y), bfhi(gw2.y)};
#pragma unroll
            for (int e = 0; e < 4; ++e) h[e] = __expf(l[e]) * h[e] + x[e];
            const f32x4 y = g * (hf[i] + h); u32x2 ow; ow.x = pk2(y[0], y[1]); ow.y = pk2(y[2], y[3]); *(u32x2*)(HG + o) = ow;
            if ((i & 7) == 0) asm volatile("" ::: "memory"); } }
}
__device__ __forceinline__ void final_phase(const float* X, const float* SSQ, const float* fnorm, float* out, int gw, int NGW, int lane) {
    for (int r = gw; r < NBATCH * SEQ; r += NGW) { const int row = 2 * CTXL + r;
        float s = lane < 32 ? SSQ[(size_t)row * 32 + lane] : 0.f; s = wave_sum(s); const float rs = 1.0f / sqrtf(s * (1.0f / D) + EPS);
#pragma unroll
        for (int j = 0; j < 8; ++j) { const int k = lane * 4 + 256 * j; *(f32x4*)(out + (size_t)r * D + k) = *(const f32x4*)(X + (size_t)row * D + k) * rs * *(const f32x4*)(fnorm + k); } }
}

constexpr int PH_P0 = 0, PH_P1 = 1, PH_PAIR0 = 2, PH_PER_PAIR = 15, PH_FINAL = PH_PAIR0 + 2 * PH_PER_PAIR, NPHASE = PH_FINAL + 1;
struct Args { const float* in[22]; float* out; unsigned char* ws; int ph_lo, ph_hi, li, pad; };
__global__ void __launch_bounds__(NTHR, 2) hyb_fwd(Args args) {
    extern __shared__ __attribute__((aligned(16))) unsigned char lds_raw[];
    LAS unsigned char* lds = (LAS unsigned char*)lds_raw;
    volatile LAS unsigned* MISC = (volatile LAS unsigned*)(lds + MISC_OFF);
    const int G = gridDim.x, NGW = G * NWAVES, NGT = G * NTHR;
#define TIDS() int tid = threadIdx.x; asm volatile("" : "+v"(tid)); const int lane = tid & 63, wave = __builtin_amdgcn_readfirstlane(tid >> 6), gw = blockIdx.x * NWAVES + wave, gt = blockIdx.x * NTHR + tid; (void)lane; (void)gw; (void)gt
    const __attribute__((address_space(4))) Args* ap = (const __attribute__((address_space(4))) Args*)__builtin_amdgcn_kernarg_segment_ptr(); asm volatile("" : "+s"(ap));
#define INP(i) (ap->in[i])
#define WSP(T, off) ((T*)(ap->ws + (off)))
#define in_x INP(0)
#define in_c INP(1)
#define in_ctx INP(2)
#define in_cctx INP(3)
#define w_mod INP(4)
#define b_mod INP(5)
#define norm1 INP(6)
#define norm2 INP(7)
#define a_w_in INP(8)
#define a_lb INP(9)
#define a_onorm INP(10)
#define a_w_out INP(11)
#define b_w_in INP(12)
#define b_conv_w INP(13)
#define b_conv_b INP(14)
#define b_gate_w INP(15)
#define b_gate_b INP(16)
#define b_lambda INP(17)
#define b_w_out INP(18)
#define mlp_w1 INP(19)
#define mlp_w2 INP(20)
#define fnorm INP(21)
#define MOD WSP(float, WS_MOD)
#define BIAS1 WSP(float, WS_BIAS1)
#define BIAS2 WSP(float, WS_BIAS2)
#define LB WSP(float, WS_LB)
#define CL WSP(float, WS_CL)
#define GM WSP(float, WS_GM)
#define SSQ WSP(float, WS_SSQ)
#define CP WSP(float, WS_CP)
#define CH WSP(float, WS_CH)
#define CIN WSP(float, WS_CIN)
#define Wb WSP(bf16, WS_W)
#define X WSP(float, WS_X)
#define XM WSP(bf16, WS_XM)
#define R0 WSP(bf16, WS_R0)
#define R1 WSP(bf16, WS_R1)
#define R2 WSP(bf16, WS_R2)
#define R3 WSP(bf16, WS_R3)
#define LF WSP(float, WS_R4)
#define LA WSP(bf16, WS_R4)
#define XI (WSP(bf16, WS_R4) + (size_t)2 * M * D)
#define HB WSP(bf16, WS_R4)
#define OB WSP(bf16, WS_R5)
    unsigned* ctl = (unsigned*)(ap->ws + WS_CTL);

    for (int u = threadIdx.x; u < (LDS_BYTES - LDSCTL_OFF) / 4; u += NTHR) ((LAS unsigned*)(lds + LDSCTL_OFF))[u] = 0u;
    __syncthreads();
    XcdBarrier bar = xcd_barrier_post(ctl + CW_BAR + ap->li * XCD_BAR_WORDS, MISC + 8);
    const int lo = ap->ph_lo, hi = ap->ph_hi;
#ifndef PHMASK
#define PHMASK 0xFFFFFFFFull
#endif
#define EN(b) (((PHMASK) >> (b)) & 1ull)
#define IN(k) (lo <= (k) && (k) < hi)
#define SEAM(k) do { if ((k) + 1 < hi) xcd_barrier(bar); } while (0)

    if (EN(0) && IN(PH_P0)) { TIDS();
        p0_mod(lds, in_c, in_cctx, w_mod, b_mod, MOD, G, tid);
        p0_tables(a_lb, b_lambda, LB, CL, gt, NGT);
        p0_weights(lds, a_w_in, a_w_out, b_w_in, b_gate_w, b_w_out, mlp_w1, mlp_w2, Wb, gw, NGW, lane, wave);
        SEAM(PH_P0);
    }
    if (EN(1) && IN(PH_P1)) { TIDS();
        p1_phase(in_x, in_ctx, norm1, norm2, MOD, GM, X, XM, SSQ, Wb, BIAS1, BIAS2, gw, NGW, gt, NGT, lane);
        SEAM(PH_P1);
    }
    for (int lp = 0; lp < 2; ++lp) {
        const int pb = PH_PAIR0 + lp * PH_PER_PAIR, la = 2 * lp, lb = 2 * lp + 1;
        if (EN(2) && IN(pb + 0)) {
            pg8::Gemm g{XM, Wb + W_INA + (size_t)lp * NA_IN * D, M, NA_IN, D, D}; pg8::StaticOrder S; S.init(M, NA_IN, G, (int)blockIdx.x);
            pg8::EpiA1 E{SSQ, BIAS1 + (size_t)la * 3 * 10240, LB + (size_t)lp * 2 * D, R0, R1, R2, LF};
            pg8::gemm_phase<pg8::EpiA1, pg8::StaticOrder, PG8_ALIGN, PG8_SP2>(lds + RING_OFF, g, S, E);
            SEAM(pb + 0);
        }
        if (EN(3) && IN(pb + 1)) { TIDS(); hgrn_scan_phase(lds, R0, R1, LF, OB, G, tid); SEAM(pb + 1); }
        if (EN(4) && IN(pb + 2)) { TIDS(); a3_phase(OB, R2, a_onorm + (size_t)lp * D, R3, gw, NGW, lane); SEAM(pb + 2); }
        if (EN(5) && IN(pb + 3)) {
            pg8::Gemm g{R3, Wb + W_OUTA + (size_t)lp * D * D, M, D, D, D}; pg8::StaticOrder S; S.init(M, D, G, (int)blockIdx.x);
            pg8::EpiRes E{X, MOD + (size_t)la * 3 * NMOD + 2 * D, GM + (size_t)(la * 2 + 1) * 3 * D, XM, SSQ};
            pg8::gemm_phase<pg8::EpiRes, pg8::StaticOrder, PG8_ALIGN, PG8_SP2>(lds + RING_OFF, g, S, E);
            SEAM(pb + 3);
        }
        if (EN(6) && IN(pb + 4)) {
            pg8::Gemm g{XM, Wb + W_1 + (size_t)la * FF * D, M, FF, D, D}; pg8::StaticOrder S; S.init(M, FF, G, (int)blockIdx.x);
            pg8::EpiMlp1 E{SSQ, BIAS2 + (size_t)la * 3 * FF, HB};
            pg8::gemm_phase<pg8::EpiMlp1, pg8::StaticOrder, PG8_ALIGN, PG8_SP2>(lds + RING_OFF, g, S, E);
            SEAM(pb + 4);
        }
        if (EN(7) && IN(pb + 5)) {
            pg8::Gemm g{HB, Wb + W_2 + (size_t)la * D * FF, M, D, FF, FF}; pg8::StaticOrder S; S.init(M, D, G, (int)blockIdx.x);
            pg8::EpiRes E{X, MOD + (size_t)la * 3 * NMOD + 5 * D, GM + (size_t)(lb * 2 + 0) * 3 * D, XM, SSQ};
            pg8::gemm_phase<pg8::EpiRes, pg8::StaticOrder, PG8_ALIGN, PG8_SP2>(lds + RING_OFF, g, S, E);
            SEAM(pb + 5);
        }
        if (EN(8) && IN(pb + 6)) {
            pg8::Gemm g{XM, Wb + W_INB + (size_t)lp * NB_IN * D, M, NB_IN, D, D}; pg8::StaticOrder S; S.init(M, NB_IN, G, (int)blockIdx.x);
            pg8::EpiB1 E{SSQ, BIAS1 + (size_t)lb * 3 * 10240, R0, R1};
            pg8::gemm_phase<pg8::EpiB1, pg8::StaticOrder, PG8_ALIGN, PG8_SP2>(lds + RING_OFF, g, S, E);
            SEAM(pb + 6);
        }
        if (EN(9) && IN(pb + 7)) { TIDS(); conv_phase(R1, b_conv_w + (size_t)lp * 4 * D, b_conv_b + (size_t)lp * D, R2, gt, NGT); SEAM(pb + 7); }
        if (EN(10) && IN(pb + 8)) {
            pg8::Gemm g{R2, Wb + W_GATE + (size_t)lp * 32 * 65536, M, 32 * 256, 256, D}; pg8::GateOrder S; S.init(M, 32 * 256, G, (int)blockIdx.x);
            pg8::EpiGate E{b_gate_b + (size_t)lp * 4 * D, CL + (size_t)lp * 2 * D, R2, LA, XI};
            pg8::gemm_phase<pg8::EpiGate, pg8::GateOrder, PG8_ALIGN, PG8_SP2>(lds + RING_OFF, g, S, E);
            SEAM(pb + 8);
        }
        if (EN(11) && IN(pb + 9)) { TIDS(); r1_phase(LA, XI, CP, CH, gt, NGT); SEAM(pb + 9); }
        if (EN(12) && IN(pb + 10)) { TIDS(); r2_phase(CP, CH, CIN, gt, NGT); SEAM(pb + 10); }
        if (EN(13) && IN(pb + 11)) { TIDS(); r3_phase(LA, XI, R0, CIN, R3, G, tid); SEAM(pb + 11); }
        if (EN(14) && IN(pb + 12)) {
            pg8::Gemm g{R3, Wb + W_OUTB + (size_t)lp * D * D, M, D, D, D}; pg8::StaticOrder S; S.init(M, D, G, (int)blockIdx.x);
            pg8::EpiRes E{X, MOD + (size_t)lb * 3 * NMOD + 2 * D, GM + (size_t)(lb * 2 + 1) * 3 * D, XM, SSQ};
            pg8::gemm_phase<pg8::EpiRes, pg8::StaticOrder, PG8_ALIGN, PG8_SP2>(lds + RING_OFF, g, S, E);
            SEAM(pb + 12);
        }
        if (EN(15) && IN(pb + 13)) {
            pg8::Gemm g{XM, Wb + W_1 + (size_t)lb * FF * D, M, FF, D, D}; pg8::StaticOrder S; S.init(M, FF, G, (int)blockIdx.x);
            pg8::EpiMlp1 E{SSQ, BIAS2 + (size_t)lb * 3 * FF, HB};
            pg8::gemm_phase<pg8::EpiMlp1, pg8::StaticOrder, PG8_ALIGN, PG8_SP2>(lds + RING_OFF, g, S, E);
            SEAM(pb + 13);
        }
        if (EN(16) && IN(pb + 14)) {
            const int ln = lb + 1 < DEPTH ? lb + 1 : lb;
            pg8::Gemm g{HB, Wb + W_2 + (size_t)lb * D * FF, M, D, FF, FF}; pg8::StaticOrder S; S.init(M, D, G, (int)blockIdx.x);
            pg8::EpiRes E{X, MOD + (size_t)lb * 3 * NMOD + 5 * D, GM + (size_t)(ln * 2 + 0) * 3 * D, XM, SSQ};
            pg8::gemm_phase<pg8::EpiRes, pg8::StaticOrder, PG8_ALIGN, PG8_SP2>(lds + RING_OFF, g, S, E);
            SEAM(pb + 14);
        }
    }
    if (EN(17) && IN(PH_FINAL)) { TIDS(); final_phase(X, SSQ, fnorm, ap->out, gw, NGW, lane); }
#undef IN
#undef SEAM
}

extern "C" void kernel_launch(void* const* d_in, const int* in_sizes, int n_in, void* d_out, int out_size, void* d_ws, size_t ws_size, hipStream_t stream) {
    static int grid = 0;
    if (grid == 0) {
        if (n_in != 22 || out_size != NBATCH * SEQ * D || ws_size < WS_END) { fprintf(stderr, "kernel_launch: unexpected shapes (n_in %d, out %d, ws %zu); nothing launched\n", n_in, out_size, ws_size); grid = -1; return; }
        int dev = 0, cus = 0, per_cu = 0;
        if (hipGetDevice(&dev) != hipSuccess || hipDeviceGetAttribute(&cus, hipDeviceAttributeMultiprocessorCount, dev) != hipSuccess) { grid = -1; return; }
        if (hipFuncSetAttribute((const void*)hyb_fwd, hipFuncAttributeMaxDynamicSharedMemorySize, LDS_BYTES) != hipSuccess) { fprintf(stderr, "kernel_launch: hipFuncSetAttribute failed\n"); grid = -1; return; }
        if (hipOccupancyMaxActiveBlocksPerMultiprocessor(&per_cu, (const void*)hyb_fwd, NTHR, LDS_BYTES) != hipSuccess || per_cu < 1) fprintf(stderr, "kernel_launch: occupancy query reports %d\n", per_cu);
        (void)hipGetLastError();
        grid = cus;
    }
    if (grid < 0) return;
    if (hipMemsetAsync((char*)d_ws + WS_CTL, 0, CTL_ZERO_BYTES, stream) != hipSuccess) return;
    Args a{};
    for (int i = 0; i < 22; ++i) a.in[i] = (const float*)d_in[i];
    a.out = (float*)d_out; a.ws = (unsigned char*)d_ws;
#if MK_ONE_LAUNCH
    a.ph_lo = 0; a.ph_hi = NPHASE; a.li = 0;
    hipLaunchKernelGGL(hyb_fwd, dim3(grid), dim3(NTHR), LDS_BYTES, stream, a);
#else
    for (int k = 0; k < NPHASE; ++k) { a.ph_lo = k; a.ph_hi = k + 1; a.li = k;
        hipLaunchKernelGGL(hyb_fwd, dim3(grid), dim3(NTHR), LDS_BYTES, stream, a); }
#endif
}
```

```cpp
#include <hip/hip_runtime.h>
#include <cstdio>
#include <cstdint>
namespace pg8 {
#define PG8_LAS __attribute__((address_space(3)))
typedef unsigned short bf16_t;
typedef short bf16x8 __attribute__((ext_vector_type(8)));
typedef float f32x4 __attribute__((ext_vector_type(4)));
typedef unsigned u32x4 __attribute__((ext_vector_type(4)));
constexpr int BM = 256, BK = 64, HALF = 128, HTB = HALF * BK * 2  , STAGE_BYTES = 8 * HTB, NXCD = 8, WGM = 8;

__host__ __device__ __forceinline__ int lds_byte(int r, int c) { const int st = (r >> 4) * 2 + (c >> 5), rr = r & 15, cc = c & 31, ob = rr * 64 + cc * 2; return st * 1024 + (ob ^ (((ob >> 9) & 1) << 5)); }
__host__ __device__ __forceinline__ void stage_rc(int b, int& R, int& C) { const int st = b / 1024, sb = b % 1024, swz = sb ^ (((sb >> 9) & 1) << 5); R = (st >> 1) * 16 + swz / 64; C = (st & 1) * 32 + (swz % 64) / 2; }
__host__ __device__ __forceinline__ int perm32(int rho) { const int n = rho >> 4, i = rho & 15; return 8 * (i >> 2) + 4 * n + (i & 3); }

struct Unit { int pm, pn; };
struct Gemm { const bf16_t* A; const bf16_t* Bt; int M, N, K, lda; };

struct StaticOrder {
    int nM, nN, nwg, G, c;
    __host__ __device__ void init(int M, int N, int G_, int c_) { nM = M / BM; nN = N / BM; nwg = nM * nN; G = G_; c = c_; }
    __host__ __device__ bool next(int i, Unit& u) const {
        const long L = (long)i * G + c; if (L >= nwg) return false;
        int wgid = (int)L; { const int q = nwg / NXCD, r = nwg % NXCD, xcd = wgid % NXCD, off = wgid / NXCD; wgid = (xcd < r ? xcd * (q + 1) : r * (q + 1) + (xcd - r) * q) + off; }
        const int nig = WGM * nN, gid = wgid / nig, fm = gid * WGM, gsz = (nM - fm) < WGM ? (nM - fm) : WGM;
        u.pm = fm + ((wgid % nig) % gsz); u.pn = (wgid % nig) / gsz; return true;
    }
    __device__ __forceinline__ void a_ready(const Unit&) const {}
    __device__ __forceinline__ int a_koff(const Unit&) const { return 0; }
    __device__ __forceinline__ void done(const Unit&) const {}
};


typedef float f32x2 __attribute__((ext_vector_type(2)));
typedef __bf16 bf16x2v __attribute__((ext_vector_type(2)));
__device__ __forceinline__ unsigned pk2(float lo, float hi) { f32x2 v = {lo, hi}; bf16x2v b = __builtin_convertvector(v, bf16x2v); return __builtin_bit_cast(unsigned, b); }
__device__ __forceinline__ u32x4 pk8(const f32x4& a, const f32x4& b) { u32x4 w; w.x = pk2(a[0], a[1]); w.y = pk2(a[2], a[3]); w.z = pk2(b[0], b[1]); w.w = pk2(b[2], b[3]); return w; }
__device__ __forceinline__ float bflo(unsigned w) { return __uint_as_float(w << 16); }
__device__ __forceinline__ float bfhi(unsigned w) { return __uint_as_float(w & 0xffff0000u); }
constexpr int ROWS = 16896, DM = 2048;
__device__ __forceinline__ int grp_of_pm(int pm) { return pm < 2 ? 0 : (pm < 34 ? 1 : 2); }
__device__ __forceinline__ float sigmoidf_(float z) { return 1.0f / (1.0f + __expf(-z)); }
__device__ __forceinline__ float one_minus_exp(float x) {
    const float p = -x * (1.0f + x * (0.5f + x * (0.16666667f + x * (0.041666668f + x * (0.0083333338f + x * 0.0013888889f)))));
    return x < -0.25f ? 1.0f - __expf(x) : fmaxf(p, 0.f);
}
__device__ __forceinline__ float row_rstd(const float* ssq, int row, int fq) {
    const f32x4 a = *(const f32x4*)(ssq + (size_t)row * 32 + fq * 8), b = *(const f32x4*)(ssq + (size_t)row * 32 + fq * 8 + 4);
    float s = ((a[0] + a[1]) + (a[2] + a[3])) + ((b[0] + b[1]) + (b[2] + b[3]));
    s += __shfl_xor(s, 16); s += __shfl_xor(s, 32);
    return 1.0f / sqrtf(s * (1.0f / 2048.0f) + 1e-6f);
}

struct EpiA1 {
    static constexpr bool PERM = true, AFTER_DRAIN = false;
    const float* ssq; const float* bias; const float* lb; bf16_t* Q; bf16_t* V; bf16_t* SG; float* LF;
    __device__ __forceinline__ void operator()(const f32x4 (&acc)[2][2][4][2], const Unit& u, int wr, int wc, int fr0, int fq0) const {
        int fr = fr0, fq = fq0; asm volatile("" : "+v"(fr), "+v"(fq));
        const int row0 = u.pm * BM + wr * 64 + fr, kind = u.pn >> 3, ct = (u.pn & 7) * BM + wc * 32 + 8 * fq, bcol = u.pn * BM + wc * 32 + 8 * fq;
        const float* bp = bias + grp_of_pm(u.pm) * 10240 + bcol;
        f32x4 bv[2][2], lbv[2][2];
#pragma unroll
        for (int bj = 0; bj < 2; ++bj)
#pragma unroll
            for (int n = 0; n < 2; ++n) { bv[bj][n] = *(const f32x4*)(bp + bj * HALF + 4 * n);
                lbv[bj][n] = kind >= 3 ? *(const f32x4*)(lb + (kind - 3) * DM + ct + bj * HALF + 4 * n) : (f32x4){0.f, 0.f, 0.f, 0.f}; }
#pragma unroll
        for (int ai = 0; ai < 2; ++ai)
#pragma unroll
            for (int m = 0; m < 4; ++m) { const int row = row0 + ai * HALF + m * 16; const float rs = row_rstd(ssq, row, fq);
#pragma unroll
                for (int bj = 0; bj < 2; ++bj) { f32x4 v0 = acc[ai][bj][m][0] * rs + bv[bj][0], v1 = acc[ai][bj][m][1] * rs + bv[bj][1];
                    const size_t off = (size_t)row * DM + ct + bj * HALF;
                    if (kind == 0) { *(u32x4*)(Q + off) = pk8(v0, v1); }
                    else if (kind == 1) { *(u32x4*)(V + off) = pk8(v0, v1); }
                    else if (kind == 2) {
#pragma unroll
                        for (int e = 0; e < 4; ++e) { v0[e] = v0[e] * sigmoidf_(v0[e]); v1[e] = v1[e] * sigmoidf_(v1[e]); }
                        *(u32x4*)(SG + off) = pk8(v0, v1); }
                    else {
#pragma unroll
                        for (int e = 0; e < 4; ++e) {
                            { const float z = v0[e], ez = __expf(-fabsf(z)), s = (z >= 0.f ? 1.0f : ez) / (1.0f + ez), l = lbv[bj][0][e]; v0[e] = fmaxf(__logf(l + (1.0f - l) * s), -80.0f); }
                            { const float z = v1[e], ez = __expf(-fabsf(z)), s = (z >= 0.f ? 1.0f : ez) / (1.0f + ez), l = lbv[bj][1][e]; v1[e] = fmaxf(__logf(l + (1.0f - l) * s), -80.0f); } }
                        float* lp = LF + (size_t)(kind - 3) * ROWS * DM + off; *(f32x4*)lp = v0; *(f32x4*)(lp + 4) = v1; } } }
    }
};
struct EpiRes {
    static constexpr bool PERM = true, AFTER_DRAIN = false;
    float* X; const float* gate; const float* gm; bf16_t* XM; float* ssq;
    __device__ __forceinline__ void operator()(const f32x4 (&acc)[2][2][4][2], const Unit& u, int wr, int wc, int fr0, int fq0) const {
        int fr = fr0, fq = fq0; asm volatile("" : "+v"(fr), "+v"(fq));
        const int row0 = u.pm * BM + wr * 64 + fr, col0 = u.pn * BM + wc * 32 + 8 * fq, grp = grp_of_pm(u.pm);
        f32x4 gv[2][2], mv[2][2];
#pragma unroll
        for (int bj = 0; bj < 2; ++bj)
#pragma unroll
            for (int n = 0; n < 2; ++n) { gv[bj][n] = *(const f32x4*)(gate + grp * 12288 + col0 + bj * HALF + 4 * n); mv[bj][n] = *(const f32x4*)(gm + grp * DM + col0 + bj * HALF + 4 * n); }
#pragma unroll
        for (int ai = 0; ai < 2; ++ai)
#pragma unroll
            for (int m = 0; m < 4; ++m) { const int row = row0 + ai * HALF + m * 16; float ss = 0.f;
#pragma unroll
                for (int bj = 0; bj < 2; ++bj) { float* xp = X + (size_t)row * DM + col0 + bj * HALF;
                    const f32x4 n0 = *(const f32x4*)xp + gv[bj][0] * acc[ai][bj][m][0], n1 = *(const f32x4*)(xp + 4) + gv[bj][1] * acc[ai][bj][m][1];
                    *(f32x4*)xp = n0; *(f32x4*)(xp + 4) = n1;
                    ss += ((n0[0] * n0[0] + n0[1] * n0[1]) + (n0[2] * n0[2] + n0[3] * n0[3])) + ((n1[0] * n1[0] + n1[1] * n1[1]) + (n1[2] * n1[2] + n1[3] * n1[3]));
                    *(u32x4*)(XM + (size_t)row * DM + col0 + bj * HALF) = pk8(n0 * mv[bj][0], n1 * mv[bj][1]); }
                ss += __shfl_xor(ss, 16); ss += __shfl_xor(ss, 32);
                if (fq == 0) ssq[(size_t)row * 32 + u.pn * 4 + wc] = ss; }
    }
};
struct EpiMlp1 {
    static constexpr bool PERM = true, AFTER_DRAIN = false;
    const float* ssq; const float* bias; bf16_t* H;
    __device__ __forceinline__ void operator()(const f32x4 (&acc)[2][2][4][2], const Unit& u, int wr, int wc, int fr0, int fq0) const {
        int fr = fr0, fq = fq0; asm volatile("" : "+v"(fr), "+v"(fq));
        const int row0 = u.pm * BM + wr * 64 + fr, col0 = u.pn * BM + wc * 32 + 8 * fq;
        const float* bp = bias + grp_of_pm(u.pm) * 8192 + col0;
        f32x4 bv[2][2];
#pragma unroll
        for (int bj = 0; bj < 2; ++bj)
#pragma unroll
            for (int n = 0; n < 2; ++n) bv[bj][n] = *(const f32x4*)(bp + bj * HALF + 4 * n);
#pragma unroll
        for (int ai = 0; ai < 2; ++ai)
#pragma unroll
            for (int m = 0; m < 4; ++m) { const int row = row0 + ai * HALF + m * 16; const float rs = row_rstd(ssq, row, fq);
#pragma unroll
                for (int bj = 0; bj < 2; ++bj) { f32x4 v0 = acc[ai][bj][m][0] * rs + bv[bj][0], v1 = acc[ai][bj][m][1] * rs + bv[bj][1];
#pragma unroll
                    for (int e = 0; e < 4; ++e) { const float a = fmaxf(v0[e], 0.f), b = fmaxf(v1[e], 0.f); v0[e] = a * a; v1[e] = b * b; }
                    *(u32x4*)(H + (size_t)row * 8192 + col0 + bj * HALF) = pk8(v0, v1); } }
    }
};
struct EpiB1 {
    static constexpr bool PERM = true, AFTER_DRAIN = false;
    const float* ssq; const float* bias; bf16_t* GY; bf16_t* UP;
    __device__ __forceinline__ void operator()(const f32x4 (&acc)[2][2][4][2], const Unit& u, int wr, int wc, int fr0, int fq0) const {
        int fr = fr0, fq = fq0; asm volatile("" : "+v"(fr), "+v"(fq));
        const int row0 = u.pm * BM + wr * 64 + fr, kind = u.pn >> 3, ct = (u.pn & 7) * BM + wc * 32 + 8 * fq, bcol = u.pn * BM + wc * 32 + 8 * fq;
        const float* bp = bias + grp_of_pm(u.pm) * 10240 + bcol;
        f32x4 bv[2][2];
#pragma unroll
        for (int bj = 0; bj < 2; ++bj)
#pragma unroll
            for (int n = 0; n < 2; ++n) bv[bj][n] = *(const f32x4*)(bp + bj * HALF + 4 * n);
#pragma unroll
        for (int ai = 0; ai < 2; ++ai)
#pragma unroll
            for (int m = 0; m < 4; ++m) { const int row = row0 + ai * HALF + m * 16; const float rs = row_rstd(ssq, row, fq);
#pragma unroll
                for (int bj = 0; bj < 2; ++bj) { f32x4 v0 = acc[ai][bj][m][0] * rs + bv[bj][0], v1 = acc[ai][bj][m][1] * rs + bv[bj][1];
                    const size_t off = (size_t)row * DM + ct + bj * HALF;
                    if (kind == 0) {
#pragma unroll
                        for (int e = 0; e < 4; ++e) { { const float y = v0[e]; v0[e] = y * sigmoidf_(1.5957691216f * (y + 0.044715f * y * y * y)); }
                                                      { const float y = v1[e]; v1[e] = y * sigmoidf_(1.5957691216f * (y + 0.044715f * y * y * y)); } }
                        *(u32x4*)(GY + off) = pk8(v0, v1); }
                    else *(u32x4*)(UP + off) = pk8(v0, v1); } }
    }
};
struct EpiGate {
    static constexpr bool PERM = true, AFTER_DRAIN = false;
    const float* gb; const float* cl; const bf16_t* U; bf16_t* LA; bf16_t* XI;
    __device__ __forceinline__ void operator()(const f32x4 (&acc)[2][2][4][2], const Unit& u, int wr, int wc, int fr0, int fq0) const {
        int fr = fr0, fq = fq0; asm volatile("" : "+v"(fr), "+v"(fq));
        const int row0 = u.pm * BM + wr * 64 + fr, d = u.pn >> 4, ch0 = (u.pn & 15) * HALF + wc * 32 + 8 * fq;
        f32x4 br[2], bi[2], cv[2];
#pragma unroll
        for (int n = 0; n < 2; ++n) { br[n] = *(const f32x4*)(gb + (d * 2 + 0) * DM + ch0 + 4 * n); bi[n] = *(const f32x4*)(gb + (d * 2 + 1) * DM + ch0 + 4 * n); cv[n] = *(const f32x4*)(cl + d * DM + ch0 + 4 * n); }
#pragma unroll
        for (int ai = 0; ai < 2; ++ai)
#pragma unroll
            for (int m = 0; m < 4; ++m) { const int row = row0 + ai * HALF + m * 16;
                const u32x4 uw = *(const u32x4*)(U + (size_t)row * DM + ch0);
                const float uf[8] = {bflo(uw.x), bfhi(uw.x), bflo(uw.y), bfhi(uw.y), bflo(uw.z), bfhi(uw.z), bflo(uw.w), bfhi(uw.w)};
                f32x4 la[2], xi[2];
#pragma unroll
                for (int n = 0; n < 2; ++n)
#pragma unroll
                    for (int e = 0; e < 4; ++e) { const float r = sigmoidf_(acc[ai][0][m][n][e] + br[n][e]), ig = sigmoidf_(acc[ai][1][m][n][e] + bi[n][e]);
                        const float l = cv[n][e] * r; la[n][e] = l; xi[n][e] = sqrtf(one_minus_exp(2.0f * l)) * ig * uf[4 * n + e]; }
                const size_t off = ((size_t)d * ROWS + row) * DM + ch0;
                *(u32x4*)(LA + off) = pk8(la[0], la[1]); *(u32x4*)(XI + off) = pk8(xi[0], xi[1]); asm volatile("" ::: "memory"); }
    }
};
struct GateOrder : StaticOrder { __device__ __forceinline__ int a_koff(const Unit& u) const { return ((u.pn & 15) >> 1) * 256; } };

template <class Epi, class Sched, bool ALIGN_EPI = false, bool SP2 = false>
__device__ __forceinline__ void gemm_phase(PG8_LAS unsigned char* lds, const Gemm g, const Sched& S, const Epi& E) {
    int tid = threadIdx.x; asm volatile("" : "+v"(tid));
    const int wid = __builtin_amdgcn_readfirstlane(tid >> 6), lane = tid & 63, wr = wid >> 2, wc = wid & 3, fr = lane & 15, fq = lane >> 4;
    int K = g.K, lda = g.lda; asm volatile("" : "+s"(K), "+s"(lda));
    const int nt = K / BK;
    unsigned voffA[2], voffB[2];
#pragma unroll
    for (int i = 0; i < 2; ++i) { int R, C; stage_rc(tid * 16 + i * 8192, R, C); const int Rb = Epi::PERM ? ((R & ~31) + perm32(R & 31)) : R;
        voffA[i] = (unsigned)(R * lda + C) * 2u; voffB[i] = (unsigned)(Rb * K + C) * 2u; }
    const size_t kstep = (size_t)(BK * 2);
    const size_t hstepA = (size_t)HALF * lda * 2, hstepB = (size_t)HALF * K * 2;
    const size_t tstepA = 2 * hstepA, tstepB = 2 * hstepB;
    const unsigned ldsw = (unsigned)wid * 1024u;
    const int aoff = lds_byte(wr * 64 + fr, fq * 8), boff = lds_byte(wc * 32 + fr, fq * 8);
#define PG8_SA(b, h) (((b) * 2 + (h)) * HTB)
#define PG8_SB(b, h) ((4 + (b) * 2 + (h)) * HTB)
#define PG8_STAGE(bufoff, gbase, voff) do { _Pragma("unroll") for (int _i = 0; _i < 2; ++_i) \
        __builtin_amdgcn_global_load_lds((const unsigned*)((const char*)(gbase) + (voff)[_i]), (PG8_LAS unsigned*)(lds + (bufoff) + ldsw + _i * 8192), 16, 0, 0); } while (0)
#define PG8_LDA(dst, b, h) do { _Pragma("unroll") for (int m = 0; m < 4; ++m) _Pragma("unroll") for (int k = 0; k < 2; ++k) dst[m][k] = *(const PG8_LAS bf16x8*)(lds + PG8_SA(b, h) + aoff + m * 2048 + k * 1024); } while (0)
#define PG8_LDB(dst, b, h) do { _Pragma("unroll") for (int n = 0; n < 2; ++n) _Pragma("unroll") for (int k = 0; k < 2; ++k) dst[n][k] = *(const PG8_LAS bf16x8*)(lds + PG8_SB(b, h) + boff + n * 2048 + k * 1024); } while (0)
#define PG8_MMA(ai, bj, At, Bt) do { __builtin_amdgcn_s_setprio(1); _Pragma("unroll") for (int m = 0; m < 4; ++m) _Pragma("unroll") for (int n = 0; n < 2; ++n) _Pragma("unroll") for (int k = 0; k < 2; ++k) \
        acc[ai][bj][m][n] = __builtin_amdgcn_mfma_f32_16x16x32_bf16(Bt[n][k], At[m][k], acc[ai][bj][m][n], 0, 0, 0); __builtin_amdgcn_s_setprio(0); } while (0)
#define PG8_WAIT_V(n) asm volatile("s_waitcnt vmcnt(" #n ")" ::: "memory")
#define PG8_WAIT_L(n) asm volatile("s_waitcnt lgkmcnt(" #n ")" ::: "memory")
#define PG8_BAR __builtin_amdgcn_s_barrier()
#define PG8_SCHED __builtin_amdgcn_sched_barrier(0)
    Unit cur, nxt; int ui = 0;
    if (!S.next(0, cur)) return;
    f32x4 acc[2][2][4][2];
#pragma unroll
    for (int a = 0; a < 2; ++a)
#pragma unroll
        for (int b = 0; b < 2; ++b)
#pragma unroll
            for (int m = 0; m < 4; ++m)
#pragma unroll
                for (int n = 0; n < 2; ++n) acc[a][b][m][n] = (f32x4){0.f, 0.f, 0.f, 0.f};
    bf16x8 At[4][2], B0[2][2], B1[2][2];
    const char* cA = (const char*)g.A + (size_t)cur.pm * tstepA + (size_t)S.a_koff(cur) * 2; const char* cB = (const char*)g.Bt + (size_t)cur.pn * tstepB;
    S.a_ready(cur);
    if constexpr (SP2) {
        PG8_STAGE(PG8_SB(0, 0), cB, voffB); PG8_STAGE(PG8_SB(0, 1), cB + hstepB, voffB); PG8_STAGE(PG8_SA(0, 0), cA, voffA); PG8_STAGE(PG8_SA(0, 1), cA + hstepA, voffA);
        if (wr == 1) PG8_BAR;
        PG8_WAIT_V(2); PG8_BAR;
        PG8_STAGE(PG8_SB(1, 0), cB + kstep, voffB); PG8_STAGE(PG8_SA(1, 0), cA + kstep, voffA); PG8_STAGE(PG8_SB(1, 1), cB + hstepB + kstep, voffB);
        PG8_WAIT_V(6); PG8_BAR;
    } else {
        PG8_STAGE(PG8_SB(0, 0), cB, voffB); PG8_STAGE(PG8_SA(0, 0), cA, voffA); PG8_STAGE(PG8_SB(0, 1), cB + hstepB, voffB); PG8_STAGE(PG8_SA(0, 1), cA + hstepA, voffA);
        if (wr == 1) PG8_BAR;
        PG8_WAIT_V(4); PG8_BAR;
        PG8_STAGE(PG8_SB(1, 0), cB + kstep, voffB); PG8_STAGE(PG8_SA(1, 0), cA + kstep, voffA); PG8_STAGE(PG8_SB(1, 1), cB + hstepB + kstep, voffB);
        PG8_WAIT_V(6); PG8_BAR;
    }
    for (;;) {
        const bool has_next = S.next(ui + 1, nxt);
        const char* nA = has_next ? (const char*)g.A + (size_t)nxt.pm * tstepA + (size_t)S.a_koff(nxt) * 2 : cA; const char* nB = has_next ? (const char*)g.Bt + (size_t)nxt.pn * tstepB : cB;
        for (int t = 0; t < nt; t += 2) {
            const bool last = (t == nt - 2);
            const char* a1 = cA + (size_t)(t + 1) * kstep;
            const char* a2 = last ? nA : cA + (size_t)(t + 2) * kstep; const char* b2 = last ? nB : cB + (size_t)(t + 2) * kstep;
            const char* a3 = a2 + kstep; const char* b3 = b2 + kstep;
            if (last && has_next) S.a_ready(nxt);
            if constexpr (SP2) {
            PG8_LDB(B0, 0, 0); PG8_LDB(B1, 0, 1); PG8_SCHED; PG8_LDA(At, 0, 0); PG8_STAGE(PG8_SA(1, 1), a1 + hstepA, voffA);
            PG8_WAIT_V(8); PG8_WAIT_L(0); PG8_BAR; PG8_MMA(0, 0, At, B0); PG8_MMA(0, 1, At, B1); PG8_BAR; PG8_SCHED;
            PG8_LDA(At, 0, 1); PG8_STAGE(PG8_SB(0, 0), b2, voffB); PG8_STAGE(PG8_SB(0, 1), b2 + hstepB, voffB); PG8_STAGE(PG8_SA(0, 0), a2, voffA);
            PG8_WAIT_V(8); PG8_WAIT_L(0); PG8_BAR; PG8_MMA(1, 0, At, B0); PG8_MMA(1, 1, At, B1); PG8_BAR; PG8_SCHED;
            PG8_LDB(B0, 1, 0); PG8_LDB(B1, 1, 1); PG8_SCHED; PG8_LDA(At, 1, 0); PG8_STAGE(PG8_SA(0, 1), a2 + hstepA, voffA);
            PG8_WAIT_V(8); PG8_WAIT_L(0); PG8_BAR; PG8_MMA(0, 0, At, B0); PG8_MMA(0, 1, At, B1); PG8_BAR; PG8_SCHED;
            PG8_LDA(At, 1, 1); PG8_STAGE(PG8_SB(1, 0), b3, voffB); PG8_STAGE(PG8_SB(1, 1), b3 + hstepB, voffB); PG8_STAGE(PG8_SA(1, 0), a3, voffA);
            PG8_WAIT_V(8); PG8_WAIT_L(0); PG8_BAR; PG8_MMA(1, 0, At, B0); PG8_MMA(1, 1, At, B1); PG8_BAR; PG8_SCHED;
            } else {
            PG8_LDB(B0, 0, 0); PG8_SCHED; PG8_LDA(At, 0, 0); PG8_STAGE(PG8_SA(1, 1), a1 + hstepA, voffA);
            PG8_WAIT_L(8); PG8_BAR; PG8_WAIT_L(0); PG8_MMA(0, 0, At, B0); PG8_BAR; PG8_SCHED;
            PG8_LDB(B1, 0, 1); PG8_STAGE(PG8_SB(0, 0), b2, voffB);
            PG8_BAR; PG8_WAIT_L(0); PG8_MMA(0, 1, At, B1); PG8_BAR;
            PG8_LDA(At, 0, 1); PG8_STAGE(PG8_SA(0, 0), a2, voffA);
            PG8_BAR; PG8_WAIT_L(0); PG8_MMA(1, 0, At, B0); PG8_BAR; PG8_SCHED;
            PG8_STAGE(PG8_SB(0, 1), b2 + hstepB, voffB);
            PG8_WAIT_V(6); PG8_BAR; PG8_MMA(1, 1, At, B1); PG8_BAR;
            PG8_LDB(B0, 1, 0); PG8_SCHED; PG8_LDA(At, 1, 0); PG8_STAGE(PG8_SA(0, 1), a2 + hstepA, voffA);
            PG8_WAIT_L(8); PG8_BAR; PG8_WAIT_L(0); PG8_MMA(0, 0, At, B0); PG8_BAR; PG8_SCHED;
            PG8_LDB(B1, 1, 1); PG8_STAGE(PG8_SB(1, 0), b3, voffB);
            PG8_BAR; PG8_WAIT_L(0); PG8_MMA(0, 1, At, B1); PG8_BAR;
            PG8_LDA(At, 1, 1); PG8_STAGE(PG8_SA(1, 0), a3, voffA);
            PG8_BAR; PG8_WAIT_L(0); PG8_MMA(1, 0, At, B0); PG8_BAR; PG8_SCHED;
            PG8_STAGE(PG8_SB(1, 1), b3 + hstepB, voffB);
            PG8_WAIT_V(6); PG8_BAR; PG8_MMA(1, 1, At, B1); PG8_BAR;
            }
        }
        if constexpr (ALIGN_EPI) { if (wr == 0) PG8_BAR; }
        if constexpr (!Epi::AFTER_DRAIN) { E(acc, cur, wr, wc, fr, fq); S.done(cur); }
        if (!has_next) break;
#pragma unroll
        for (int a = 0; a < 2; ++a)
#pragma unroll
            for (int b = 0; b < 2; ++b)
#pragma unroll
                for (int m = 0; m < 4; ++m)
#pragma unroll
                    for (int n = 0; n < 2; ++n) acc[a][b][m][n] = (f32x4){0.f, 0.f, 0.f, 0.f};
        cur = nxt; cA = nA; cB = nB; ++ui;
        if constexpr (ALIGN_EPI) { if (wr == 1) PG8_BAR; }
    }
    PG8_WAIT_V(0);
    if constexpr (!ALIGN_EPI) { if (wr == 0) PG8_BAR; }
    PG8_BAR;
    if constexpr (Epi::AFTER_DRAIN) { E.fused(acc, cur, wr, wc, fr, fq, lds, wid, lane); S.done(cur); }
#undef PG8_SA
#undef PG8_SB
#undef PG8_STAGE
#undef PG8_LDA
#undef PG8_LDB
#undef PG8_MMA
#undef PG8_WAIT_V
#undef PG8_WAIT_L
#undef PG8_BAR
#undef PG8_SCHED
}
}

#ifndef PG8_SP2
#define PG8_SP2 true
#endif
#ifndef PG8_ALIGN
#define PG8_ALIGN true
#endif
#ifndef MK_ONE_LAUNCH
#define MK_ONE_LAUNCH 1
#endif

constexpr int NWAVES = 8, NTHR = 512;
constexpr int D = 2048, NBATCH = 2, SEQ = 8192, CTXL = 256, DEPTH = 4, FF = 8192, TSEQ = SEQ + CTXL;
constexpr int M = NBATCH * TSEQ;
constexpr int NA_IN = 5 * D, NB_IN = 2 * D, NMOD = 6 * D;
constexpr int NSEG = TSEQ / 32;
constexpr float EPS = 1e-6f;
static_assert(M == pg8::ROWS && D == pg8::DM, "shapes");

constexpr size_t MiB = 1u << 20;
constexpr size_t WS_CTL = 0, CTL_ZERO_BYTES = 1 * MiB;
constexpr size_t WS_MOD = 1 * MiB;
constexpr size_t WS_BIAS1 = 2 * MiB;
constexpr size_t WS_BIAS2 = 3 * MiB;
constexpr size_t WS_LB = 4 * MiB;
constexpr size_t WS_CL = WS_LB + 65536, WS_GM = WS_LB + 131072;
constexpr size_t WS_SSQ = 5 * MiB;
constexpr size_t WS_CP = 8 * MiB, WS_CH = 17 * MiB, WS_CIN = 26 * MiB;
constexpr size_t WS_W = 64 * MiB;
constexpr size_t W_INA = 0, W_OUTA = W_INA + 2ull * NA_IN * D, W_INB = W_OUTA + 2ull * D * D, W_GATE = W_INB + 2ull * NB_IN * D, W_OUTB = W_GATE + 2ull * 32 * 256 * 256,
                 W_1 = W_OUTB + 2ull * D * D, W_2 = W_1 + 4ull * FF * D, W_END = W_2 + 4ull * FF * D;
static_assert(W_END * 2 <= 416 * MiB, "weights region");
constexpr size_t WS_X = 480 * MiB;
constexpr size_t WS_XM = 612 * MiB;
constexpr size_t WS_R0 = 678 * MiB, WS_R1 = 744 * MiB, WS_R2 = 810 * MiB, WS_R3 = 876 * MiB;
constexpr size_t WS_R4 = 942 * MiB;
constexpr size_t WS_R5 = 1206 * MiB;
constexpr size_t WS_END = 1338 * MiB;
constexpr int CW_BAR = 4096;

constexpr int RING_OFF = 0, RING_BYTES = 131072;
constexpr int LDSCTL_OFF = RING_BYTES, MISC_OFF = LDSCTL_OFF + 320;
constexpr int LDS_BYTES = 147456;

#define GAS __attribute__((address_space(1)))
#define LAS __attribute__((address_space(3)))
typedef unsigned short bf16;
typedef float f32x4 __attribute__((ext_vector_type(4)));
typedef float f32x2 __attribute__((ext_vector_type(2)));
typedef short bf16x8 __attribute__((ext_vector_type(8)));
typedef unsigned u32x4 __attribute__((ext_vector_type(4)));
typedef unsigned u32x2 __attribute__((ext_vector_type(2)));
using pg8::pk2; using pg8::pk8; using pg8::bflo; using pg8::bfhi;
#define LDS_WAIT() asm volatile("s_waitcnt lgkmcnt(0)" ::: "memory")

#define XB_TMO      128
#define XB_XCNT(j)  (256  + 64 * (j))
#define XB_XSUB(j)  (1280 + 64 * (j))
#define XB_XGEN(j)  (2304 + 64 * (j))
#define XB_TOP      3328
#define XB_TOPGEN   3392
#define XCD_BAR_WORDS 3456
#define XB_SPIN_CAP (1u << 18)
__device__ __forceinline__ unsigned xb_ld(unsigned* p)              { return __hip_atomic_load(p, __ATOMIC_RELAXED, __HIP_MEMORY_SCOPE_AGENT); }
__device__ __forceinline__ unsigned xb_add(unsigned* p, unsigned v) { return __hip_atomic_fetch_add(p, v, __ATOMIC_RELAXED, __HIP_MEMORY_SCOPE_AGENT); }
__device__ __forceinline__ unsigned xb_xcc_id() { return (unsigned)__builtin_amdgcn_s_getreg((3 << 11) | 20) & 0xFu; }
#define XB_SPIN(cond, bar) do { unsigned _sp = 0; while (cond) { __builtin_amdgcn_s_sleep(1); \
    if ((++_sp & 255u) == 0u) { if (xb_ld(&(bar)[XB_TMO])) break; if (_sp > XB_SPIN_CAP) { atomicAdd(&(bar)[XB_TMO], 1u); break; } } } } while (0)
struct XcdBarrier { unsigned* bar; unsigned x; volatile LAS unsigned* st; };
__device__ __forceinline__ XcdBarrier xcd_barrier_post(unsigned* bar, volatile LAS unsigned* st) {
    XcdBarrier b; b.bar = bar; b.x = xb_xcc_id(); b.st = st;
    if (threadIdx.x == 0) (void)xb_add(&bar[XB_XCNT(b.x)], 1u);
    return b;
}
__device__ __forceinline__ void xcd_barrier_complete(unsigned* bar, unsigned x, unsigned& nloc, unsigned& nx) {
    const unsigned G = gridDim.x * gridDim.y * gridDim.z;
    unsigned sum, cnt, mine, sp = 0u;
    for (;;) {
        sum = 0u; cnt = 0u; mine = 0u;
#pragma unroll
        for (unsigned j = 0; j < 16; ++j) { const unsigned c = xb_ld(&bar[XB_XCNT(j)]); sum += c; cnt += (c > 0u) ? 1u : 0u; mine = (j == x) ? c : mine; }
        if (sum == G) break;
        __builtin_amdgcn_s_sleep(1);
        if ((++sp & 255u) == 0u) { if (xb_ld(&bar[XB_TMO])) break; if (sp > XB_SPIN_CAP) { atomicAdd(&bar[XB_TMO], 1u); break; } }
    }
    nloc = mine > 0u ? mine : 1u; nx = cnt > 0u ? cnt : 1u;
}
__device__ __forceinline__ void xcd_barrier(const XcdBarrier& b) {
    asm volatile("s_waitcnt vmcnt(0)" ::: "memory");
    __syncthreads();
    if (threadIdx.x == 0) {
        unsigned* bar = b.bar;
        __builtin_amdgcn_s_waitcnt(0);
        unsigned nloc = b.st[0], nx = b.st[1];
        if (nloc == 0u) { xcd_barrier_complete(bar, b.x, nloc, nx); b.st[0] = nloc; b.st[1] = nx; }
        const unsigned old = xb_add(&bar[XB_XSUB(b.x)], 1u);
        const unsigned gen = old / nloc;
        if (old + 1u == (gen + 1u) * nloc) {
            __builtin_amdgcn_fence(__ATOMIC_RELEASE, "agent");
            asm volatile("s_waitcnt vmcnt(0)" ::: "memory");
            const unsigned og = xb_add(&bar[XB_TOP], 1u);
            const unsigned tg = og / nx;
            if (og + 1u == (tg + 1u) * nx) xb_add(&bar[XB_TOPGEN], 1u);
            else XB_SPIN(xb_ld(&bar[XB_TOPGEN]) == tg, bar);
            __builtin_amdgcn_fence(__ATOMIC_ACQUIRE, "agent");
            xb_add(&bar[XB_XGEN(b.x)], 1u);
            asm volatile("s_waitcnt vmcnt(0)" ::: "memory");
        } else {
            XB_SPIN(xb_ld(&bar[XB_XGEN(b.x)]) == gen, bar);
            __builtin_amdgcn_fence(__ATOMIC_ACQUIRE, "agent");
            asm volatile("s_waitcnt vmcnt(0)" ::: "memory");
        }
    }
    __syncthreads();
}

__device__ __forceinline__ float wave_sum(float v) {
#pragma unroll
    for (int o = 1; o < 64; o <<= 1) v += __shfl_xor(v, o);
    return v;
}
__device__ __forceinline__ int row_of(int b, int tau) { return tau < CTXL ? b * CTXL + tau : 2 * CTXL + b * SEQ + (tau - CTXL); }
__device__ __forceinline__ float siluf_(float v) { return v / (1.0f + __expf(-v)); }

template <class RowMap>
__device__ __forceinline__ void transpose_item(const float* W, int K, int N, bf16* WT, const RowMap& rm, LAS float* scr, int item, int lane) {
    const int nblk = N / 32, kb = item / nblk, nb = item % nblk, k0 = 64 * kb, n0 = 32 * nb;
#pragma unroll 8
    for (int i = 0; i < 32; ++i) { const int kk = 2 * i + (lane >> 5); scr[kk * 33 + (lane & 31)] = W[(size_t)(k0 + kk) * N + n0 + (lane & 31)]; }
    LDS_WAIT(); asm volatile("" ::: "memory");
    const int c = lane & 7;
#pragma unroll
    for (int j = 0; j < 4; ++j) { const int n = (lane >> 3) + 8 * j; const LAS float* s = scr + (8 * c) * 33 + n;
        u32x4 o; o.x = pk2(s[0 * 33], s[1 * 33]); o.y = pk2(s[2 * 33], s[3 * 33]); o.z = pk2(s[4 * 33], s[5 * 33]); o.w = pk2(s[6 * 33], s[7 * 33]);
        *(GAS u32x4*)(WT + (size_t)rm(n0 + n) * K + k0 + 8 * c) = o; }
    LDS_WAIT(); asm volatile("" ::: "memory");
}
struct RowId { __device__ __forceinline__ int operator()(int n) const { return n; } };
struct RowGate { int d, gi, nblk; __device__ __forceinline__ int operator()(int c) const { return (d * 16 + 2 * nblk + (c >> 7)) * 256 + gi * 128 + (c & 127); } };

__device__ __forceinline__ void p0_mod(LAS unsigned char* lds, const float* c, const float* c_ctx, const float* w_mod, const float* b_mod, float* MOD, int G, int tid) {
    LAS float* sil = (LAS float*)(lds + 81920);
    LAS float* red = (LAS float*)(lds + 106496);
    const int lane = tid & 63, w = tid >> 6;
    bool have = false;
    for (int it = blockIdx.x; it < 192; it += G) {
        if (!have) { for (int i = tid; i < 3 * D; i += NTHR) { const int g = i / D, k = i % D; const float v = g == 0 ? c_ctx[k] : c[(g - 1) * D + k]; sil[i] = siluf_(v); } __syncthreads(); have = true; }
        const int l = it / 48, cb = it % 48, n0 = cb * 256 + lane * 4;
        f32x4 a0 = {0.f, 0.f, 0.f, 0.f}, a1 = a0, a2 = a0;
        const float* wp = w_mod + ((size_t)l * D + w * 256) * NMOD + n0;
#pragma unroll 8
        for (int k = 0; k < 256; ++k) { const f32x4 wv = *(const f32x4*)(wp + (size_t)k * NMOD); const int kk = w * 256 + k; a0 += sil[kk] * wv; a1 += sil[D + kk] * wv; a2 += sil[2 * D + kk] * wv; }
        *(LAS f32x4*)(red + (w * 3 + 0) * 256 + lane * 4) = a0; *(LAS f32x4*)(red + (w * 3 + 1) * 256 + lane * 4) = a1; *(LAS f32x4*)(red + (w * 3 + 2) * 256 + lane * 4) = a2;
        __syncthreads();
        for (int i = tid; i < 768; i += NTHR) { const int g = i >> 8, col = i & 255; float s = 0.f;
#pragma unroll
            for (int w2 = 0; w2 < 8; ++w2) s += red[(w2 * 3 + g) * 256 + col];
            const int n = cb * 256 + col; MOD[(size_t)(l * 3 + g) * NMOD + n] = s + b_mod[(size_t)l * NMOD + n]; }
        __syncthreads();
    }
}
struct RowGen { int mode, d, gi, nblk; __device__ __forceinline__ int operator()(int n) const { return mode ? (d * 16 + 2 * nblk + (n >> 7)) * 256 + gi * 128 + (n & 127) : n; } };
__device__ __forceinline__ void p0_weights(LAS unsigned char* lds, const float* a_w_in, const float* a_w_out, const float* b_w_in, const float* b_gate_w, const float* b_w_out, const float* mlp_w1, const float* mlp_w2,
                                           bf16* Wb, int gw, int NGW, int lane, int wave) {
    LAS float* scr = (LAS float*)(lds + wave * 8448);
    constexpr int I_INA = (D / 64) * (NA_IN / 32), I_DD = (D / 64) * (D / 32), I_INB = (D / 64) * (NB_IN / 32), I_G = 4 * 8, I_1 = (D / 64) * (FF / 32), I_2 = (FF / 64) * (D / 32);
    constexpr int NITEMS = 2 * I_INA + 2 * I_DD + 2 * I_INB + 64 * I_G + 2 * I_DD + 4 * I_1 + 4 * I_2;
    for (int it = gw; it < NITEMS; it += NGW) {
        int r = it; const float* src; bf16* dst; int K, N, item; RowGen rm{0, 0, 0, 0};
        if (r < 2 * I_INA) { const int j = r / I_INA; item = r % I_INA; src = a_w_in + (size_t)j * D * NA_IN; dst = Wb + W_INA + (size_t)j * NA_IN * D; K = D; N = NA_IN; }
        else if ((r -= 2 * I_INA) < 2 * I_DD) { const int j = r / I_DD; item = r % I_DD; src = a_w_out + (size_t)j * D * D; dst = Wb + W_OUTA + (size_t)j * D * D; K = D; N = D; }
        else if ((r -= 2 * I_DD) < 2 * I_INB) { const int j = r / I_INB; item = r % I_INB; src = b_w_in + (size_t)j * D * NB_IN; dst = Wb + W_INB + (size_t)j * NB_IN * D; K = D; N = NB_IN; }
        else if ((r -= 2 * I_INB) < 64 * I_G) { const int mi = r / I_G; item = r % I_G; src = b_gate_w + (size_t)mi * 65536; const int j = mi >> 5; dst = Wb + W_GATE + (size_t)j * 32 * 65536; K = 256; N = 256;
            rm.mode = 1; rm.d = (mi >> 4) & 1; rm.gi = (mi >> 3) & 1; rm.nblk = mi & 7; }
        else if ((r -= 64 * I_G) < 2 * I_DD) { const int j = r / I_DD; item = r % I_DD; src = b_w_out + (size_t)j * D * D; dst = Wb + W_OUTB + (size_t)j * D * D; K = D; N = D; }
        else if ((r -= 2 * I_DD) < 4 * I_1) { const int l = r / I_1; item = r % I_1; src = mlp_w1 + (size_t)l * D * FF; dst = Wb + W_1 + (size_t)l * FF * D; K = D; N = FF; }
        else { r -= 4 * I_1; const int l = r / I_2; item = r % I_2; src = mlp_w2 + (size_t)l * FF * D; dst = Wb + W_2 + (size_t)l * D * FF; K = FF; N = D; }
        transpose_item(src, K, N, dst, rm, scr, item, lane);
    }
}
__device__ __forceinline__ void p0_tables(const float* a_lb, const float* b_lambda, float* LB, float* CL, int gt, int NGT) {
    for (int i = gt; i < 2 * D; i += NGT) { const float l0 = a_lb[i], l1 = a_lb[2 * D + i], mx = fmaxf(l0, l1), e0 = expf(l0 - mx), e1 = expf(l1 - mx); LB[i] = 0.f; LB[2 * D + i] = e1 / (e0 + e1); }
    for (int i = gt; i < 4 * D; i += NGT) CL[i] = -8.0f * log1pf(expf(-b_lambda[i]));
}

__device__ __forceinline__ void p1_phase(const float* xin, const float* ctx, const float* norm1, const float* norm2, const float* MOD, float* GM, float* X, bf16* XM, float* SSQ,
                                         const bf16* Wb, float* BIAS1, float* BIAS2, int gw, int NGW, int gt, int NGT, int lane) {
    for (int i = gt; i < DEPTH * 2 * 3 * D; i += NGT) { const int k = i % D, g = (i / D) % 3, wh = (i / (3 * D)) & 1, l = i / (6 * D);
        GM[i] = (wh ? norm2 : norm1)[l * D + k] * (1.0f + MOD[(size_t)(l * 3 + g) * NMOD + (wh ? 4 : 1) * D + k]); }
    for (int row = gw; row < M; row += NGW) {
        const float* src = row < 2 * CTXL ? ctx + (size_t)row * D : xin + (size_t)(row - 2 * CTXL) * D;
        const int g = row < 2 * CTXL ? 0 : (row < 2 * CTXL + SEQ ? 1 : 2);
        f32x4 v[8]; float ss = 0.f;
#pragma unroll
        for (int j = 0; j < 8; ++j) { v[j] = *(const f32x4*)(src + lane * 4 + 256 * j); ss += (v[j][0] * v[j][0] + v[j][1] * v[j][1]) + (v[j][2] * v[j][2] + v[j][3] * v[j][3]); }
        ss = wave_sum(ss);
#pragma unroll
        for (int j = 0; j < 8; ++j) { const int k = lane * 4 + 256 * j; *(f32x4*)(X + (size_t)row * D + k) = v[j];
            const f32x4 gm = *(const f32x4*)(norm1 + k) * (1.0f + *(const f32x4*)(MOD + (size_t)g * NMOD + D + k)); const f32x4 y = v[j] * gm;
            u32x2 o; o.x = pk2(y[0], y[1]); o.y = pk2(y[2], y[3]); *(u32x2*)(XM + (size_t)row * D + k) = o; }
        if (lane < 32) SSQ[(size_t)row * 32 + lane] = lane == 0 ? ss : 0.f;
    }
    for (int r = gw; r < 2 * NA_IN + 2 * NB_IN + 4 * FF; r += NGW) {
        const bf16* wrow; const float* sh; float* out; int ostride;
        if (r < 2 * NA_IN) { const int j = r / NA_IN, n = r % NA_IN, l = 2 * j; wrow = Wb + W_INA + ((size_t)j * NA_IN + n) * D; sh = MOD + (size_t)l * 3 * NMOD; out = BIAS1 + (size_t)l * 3 * 10240 + n; ostride = 10240; }
        else if (r < 2 * NA_IN + 2 * NB_IN) { const int r2 = r - 2 * NA_IN, j = r2 / NB_IN, n = r2 % NB_IN, l = 2 * j + 1; wrow = Wb + W_INB + ((size_t)j * NB_IN + n) * D; sh = MOD + (size_t)l * 3 * NMOD; out = BIAS1 + (size_t)l * 3 * 10240 + n; ostride = 10240; }
        else { const int r2 = r - 2 * NA_IN - 2 * NB_IN, l = r2 / FF, n = r2 % FF; wrow = Wb + W_1 + ((size_t)l * FF + n) * D; sh = MOD + (size_t)l * 3 * NMOD + 3 * D; out = BIAS2 + (size_t)l * 3 * FF + n; ostride = FF; }
        float s0 = 0.f, s1 = 0.f, s2 = 0.f;
#pragma unroll
        for (int j = 0; j < 4; ++j) { const int k = lane * 8 + 512 * j; const u32x4 ww = *(const u32x4*)(wrow + k);
            const float wf[8] = {bflo(ww.x), bfhi(ww.x), bflo(ww.y), bfhi(ww.y), bflo(ww.z), bfhi(ww.z), bflo(ww.w), bfhi(ww.w)};
#pragma unroll
            for (int e = 0; e < 8; ++e) { s0 += wf[e] * sh[k + e]; s1 += wf[e] * sh[NMOD + k + e]; s2 += wf[e] * sh[2 * NMOD + k + e]; } }
        s0 = wave_sum(s0); s1 = wave_sum(s1); s2 = wave_sum(s2);
        if (lane == 0) { out[0] = s0; out[ostride] = s1; out[2 * ostride] = s2; }
    }
}

constexpr int H3_QT = 0, H3_KT = 8704, H3_KH = 17408, H3_VT = 27648, H3_DEC = 37888, H3_BUF = 38400;
static_assert(2 * H3_BUF <= RING_BYTES, "H3 LDS");
__device__ __forceinline__ bf16x8 frag16(const LAS unsigned char* p) { return *(const LAS bf16x8*)p; }
__device__ __forceinline__ bf16x8 frag8x2(const LAS unsigned char* p0, const LAS unsigned char* p1) { const u32x2 a = *(const LAS u32x2*)p0, b = *(const LAS u32x2*)p1; const u32x4 w = {a.x, a.y, b.x, b.y}; return __builtin_bit_cast(bf16x8, w); }
#define MFMA16(a, b, c) __builtin_amdgcn_mfma_f32_16x16x32_bf16((a), (b), (c), 0, 0, 0)
__device__ __forceinline__ void hgrn_scan_phase(LAS unsigned char* lds, const bf16* Q, const bf16* V, const float* LF, bf16* O, int G, int tid) {
    const int lane = tid & 63, w = __builtin_amdgcn_readfirstlane(tid >> 6);
    const int c = lane & 15, q4 = lane >> 4, dq = lane & 3, tp = lane >> 2, vi = tid >> 4, vd8 = (tid & 15) * 8, dv0 = 16 * w;
    constexpr int NCH = TSEQ / 32;
    for (int item = blockIdx.x; item < 64; item += G) {
        const int b = item >> 5, dir = (item >> 4) & 1, h = item & 15, sgn = dir ? -1 : 1, hoff = h * 128;
        const float* LFd = LF + (size_t)dir * M * D; bf16* Od = O + (size_t)dir * M * D;
        f32x4 St[8];
#pragma unroll
        for (int t = 0; t < 8; ++t) St[t] = (f32x4){0.f, 0.f, 0.f, 0.f};
        f32x4 lf0A, lf1A, lf0B, lf1B; u32x2 qq0A, qq1A, qq0B, qq1B; u32x4 vvA, vvB;
#define H3_RBASE(cc) ((32 * (cc) < CTXL) ? (b * CTXL + (dir ? CTXL - 1 - 32 * (cc) : 32 * (cc))) : (2 * CTXL + b * SEQ + (dir ? SEQ - 1 - (32 * (cc) - CTXL) : (32 * (cc) - CTXL))))
#define H3_LOAD(S, cc) do { const int rb_ = H3_RBASE(cc); const int r0_ = rb_ + sgn * (2 * tp), r1_ = r0_ + sgn; const int co_ = hoff + 16 * w + 4 * dq; \
            lf0##S = *(const f32x4*)(LFd + (size_t)r0_ * D + co_); lf1##S = *(const f32x4*)(LFd + (size_t)r1_ * D + co_); \
            qq0##S = *(const u32x2*)(Q + (size_t)r0_ * D + co_); qq1##S = *(const u32x2*)(Q + (size_t)r1_ * D + co_); \
            vv##S = *(const u32x4*)(V + (size_t)(rb_ + sgn * vi) * D + hoff + vd8); } while (0)
#define H3_PREP(S, bo) do { LAS unsigned char* B_ = lds + (bo); f32x4 x_ = lf0##S + lf1##S; \
            _Pragma("unroll") for (int off_ = 4; off_ < 64; off_ <<= 1) { f32x4 y_; _Pragma("unroll") for (int e = 0; e < 4; ++e) y_[e] = __shfl_up(x_[e], off_); if (lane >= off_) x_ += y_; } \
            f32x4 bC_, eC_; _Pragma("unroll") for (int e = 0; e < 4; ++e) { bC_[e] = __shfl(x_[e], 60 + dq); eC_[e] = __expf(bC_[e]); } \
            const f32x4 b1_ = x_, b0_ = x_ - lf1##S; \
            const float qf0_[4] = {bflo(qq0##S.x), bfhi(qq0##S.x), bflo(qq0##S.y), bfhi(qq0##S.y)}, qf1_[4] = {bflo(qq1##S.x), bfhi(qq1##S.x), bflo(qq1##S.y), bfhi(qq1##S.y)}; \
            f32x4 qt0_, kt0_, kh0_, qt1_, kt1_, kh1_; \
            _Pragma("unroll") for (int e = 0; e < 4; ++e) { \
                { const float k_ = 1.0f - __expf(lf0##S[e]); qt0_[e] = qf0_[e] * __expf(b0_[e]); kt0_[e] = k_ * __expf(-b0_[e]); kh0_[e] = kt0_[e] * eC_[e]; } \
                { const float k_ = 1.0f - __expf(lf1##S[e]); qt1_[e] = qf1_[e] * __expf(b1_[e]); kt1_[e] = k_ * __expf(-b1_[e]); kh1_[e] = kt1_[e] * eC_[e]; } } \
            const int dko_ = 16 * w + 4 * dq; \
            { u32x2 o_; o_.x = pk2(qt0_[0], qt0_[1]); o_.y = pk2(qt0_[2], qt0_[3]); *(LAS u32x2*)(B_ + H3_QT + (2 * tp) * 272 + dko_ * 2) = o_; } \
            { u32x2 o_; o_.x = pk2(qt1_[0], qt1_[1]); o_.y = pk2(qt1_[2], qt1_[3]); *(LAS u32x2*)(B_ + H3_QT + (2 * tp + 1) * 272 + dko_ * 2) = o_; } \
            { u32x2 o_; o_.x = pk2(kt0_[0], kt0_[1]); o_.y = pk2(kt0_[2], kt0_[3]); *(LAS u32x2*)(B_ + H3_KT + (2 * tp) * 272 + dko_ * 2) = o_; } \
            { u32x2 o_; o_.x = pk2(kt1_[0], kt1_[1]); o_.y = pk2(kt1_[2], kt1_[3]); *(LAS u32x2*)(B_ + H3_KT + (2 * tp + 1) * 272 + dko_ * 2) = o_; } \
            _Pragma("unroll") for (int e = 0; e < 4; ++e) *(LAS unsigned*)(B_ + H3_KH + (dko_ + e) * 80 + (2 * tp) * 2) = pk2(kh0_[e], kh1_[e]); \
            if (tp == 15) *(LAS f32x4*)(B_ + H3_DEC + dko_ * 4) = eC_; \
            { const unsigned vw_[4] = {vv##S.x, vv##S.y, vv##S.z, vv##S.w}; \
              _Pragma("unroll") for (int e = 0; e < 4; ++e) { *(LAS unsigned short*)(B_ + H3_VT + (vd8 + 2 * e) * 80 + vi * 2) = (unsigned short)(vw_[e] & 0xffffu); \
                                                             *(LAS unsigned short*)(B_ + H3_VT + (vd8 + 2 * e + 1) * 80 + vi * 2) = (unsigned short)(vw_[e] >> 16); } } \
        } while (0)
#define H3_MMA(bo, cc) do { const LAS unsigned char* B_ = lds + (bo); \
            f32x4 X00 = {0.f, 0.f, 0.f, 0.f}, X01 = X00, X11 = X00; \
            _Pragma("unroll") for (int ks = 0; ks < 4; ++ks) { const int ko_ = (32 * ks + 8 * q4) * 2; \
                const bf16x8 a0_ = frag16(B_ + H3_KT + c * 272 + ko_), a1_ = frag16(B_ + H3_KT + (16 + c) * 272 + ko_), b0_ = frag16(B_ + H3_QT + c * 272 + ko_), b1_ = frag16(B_ + H3_QT + (16 + c) * 272 + ko_); \
                X00 = MFMA16(a0_, b0_, X00); X01 = MFMA16(a0_, b1_, X01); X11 = MFMA16(a1_, b1_, X11); } \
            _Pragma("unroll") for (int r_ = 0; r_ < 4; ++r_) if (4 * q4 + r_ > c) { X00[r_] = 0.f; X11[r_] = 0.f; } \
            const bf16x8 va_ = frag8x2(B_ + H3_VT + (dv0 + c) * 80 + 8 * q4, B_ + H3_VT + (dv0 + c) * 80 + 32 + 8 * q4); \
            const u32x4 xw0_ = {pk2(X00[0], X00[1]), pk2(X00[2], X00[3]), 0u, 0u}, xw1_ = {pk2(X01[0], X01[1]), pk2(X01[2], X01[3]), pk2(X11[0], X11[1]), pk2(X11[2], X11[3])}; \
            f32x4 OT0 = {0.f, 0.f, 0.f, 0.f}, OT1 = OT0; \
            OT0 = MFMA16(va_, __builtin_bit_cast(bf16x8, xw0_), OT0); OT1 = MFMA16(va_, __builtin_bit_cast(bf16x8, xw1_), OT1); \
            _Pragma("unroll") for (int ks = 0; ks < 4; ++ks) { const u32x4 sw_ = pk8(St[2 * ks], St[2 * ks + 1]); const bf16x8 sa_ = __builtin_bit_cast(bf16x8, sw_); \
                const int k0_ = (32 * ks + 4 * q4) * 2, k1_ = (32 * ks + 16 + 4 * q4) * 2; \
                const bf16x8 qb0_ = frag8x2(B_ + H3_QT + c * 272 + k0_, B_ + H3_QT + c * 272 + k1_), qb1_ = frag8x2(B_ + H3_QT + (16 + c) * 272 + k0_, B_ + H3_QT + (16 + c) * 272 + k1_); \
                OT0 = MFMA16(sa_, qb0_, OT0); OT1 = MFMA16(sa_, qb1_, OT1); } \
            { const int rb_ = H3_RBASE(cc); u32x2 o0_, o1_; o0_.x = pk2(OT0[0], OT0[1]); o0_.y = pk2(OT0[2], OT0[3]); o1_.x = pk2(OT1[0], OT1[1]); o1_.y = pk2(OT1[2], OT1[3]); \
              *(u32x2*)(Od + (size_t)(rb_ + sgn * c) * D + hoff + dv0 + 4 * q4) = o0_; *(u32x2*)(Od + (size_t)(rb_ + sgn * (16 + c)) * D + hoff + dv0 + 4 * q4) = o1_; } \
            const bf16x8 vb_ = frag16(B_ + H3_VT + (dv0 + c) * 80 + 16 * q4); \
            _Pragma("unroll") for (int t = 0; t < 8; ++t) { const bf16x8 ka_ = frag16(B_ + H3_KH + (16 * t + c) * 80 + 16 * q4); const f32x4 dec_ = *(const LAS f32x4*)(B_ + H3_DEC + (16 * t + 4 * q4) * 4); \
                St[t] = MFMA16(ka_, vb_, St[t] * dec_); } \
        } while (0)
        H3_LOAD(A, 0); H3_LOAD(B, 1);
        H3_PREP(A, 0); H3_LOAD(A, 2);
        __syncthreads();
        for (int cc = 0; cc < NCH; cc += 2) {
            if (cc + 1 < NCH) { H3_PREP(B, H3_BUF); if (cc + 3 < NCH) H3_LOAD(B, cc + 3); }
            H3_MMA(0, cc);
            __syncthreads();
            if (cc + 2 < NCH) { H3_PREP(A, 0); if (cc + 4 < NCH) H3_LOAD(A, cc + 4); }
            if (cc + 1 < NCH) H3_MMA(H3_BUF, cc + 1);
            __syncthreads();
        }
#undef H3_LOAD
#undef H3_PREP
#undef H3_MMA
#undef H3_RBASE
    }
}

__device__ __forceinline__ void a3_phase(const bf16* O, const bf16* SG, const float* onorm, bf16* OG, int gw, int NGW, int lane) {
    for (int it = gw; it < M * 4; it += NGW) { const int row = it >> 2, c8 = (it & 3) * 512 + lane * 8;
        const u32x4 a = *(const u32x4*)(O + (size_t)row * D + c8), b = *(const u32x4*)(O + ((size_t)M + row) * D + c8), s = *(const u32x4*)(SG + (size_t)row * D + c8);
        const f32x4 n0 = *(const f32x4*)(onorm + c8), n1 = *(const f32x4*)(onorm + c8 + 4);
        float o[8] = {bflo(a.x) + bflo(b.x), bfhi(a.x) + bfhi(b.x), bflo(a.y) + bflo(b.y), bfhi(a.y) + bfhi(b.y), bflo(a.z) + bflo(b.z), bfhi(a.z) + bfhi(b.z), bflo(a.w) + bflo(b.w), bfhi(a.w) + bfhi(b.w)};
        const float sg[8] = {bflo(s.x), bfhi(s.x), bflo(s.y), bfhi(s.y), bflo(s.z), bfhi(s.z), bflo(s.w), bfhi(s.w)};
        float ss = 0.f;
#pragma unroll
        for (int e = 0; e < 8; ++e) ss += o[e] * o[e];
        ss += __shfl_xor(ss, 1); ss += __shfl_xor(ss, 2); ss += __shfl_xor(ss, 4); ss += __shfl_xor(ss, 8);
        const float r = 1.0f / sqrtf(ss * (1.0f / 128.0f) + EPS);
#pragma unroll
        for (int e = 0; e < 8; ++e) o[e] = o[e] * r * (e < 4 ? n0[e & 3] : n1[e & 3]) * sg[e];
        u32x4 y; y.x = pk2(o[0], o[1]); y.y = pk2(o[2], o[3]); y.z = pk2(o[4], o[5]); y.w = pk2(o[6], o[7]);
        *(u32x4*)(OG + (size_t)row * D + c8) = y; }
}
__device__ __forceinline__ void conv_phase(const bf16* UP, const float* cw, const float* cb, bf16* U, int gt, int NGT) {
    for (int idx = gt; idx < M * 256; idx += NGT) { const int row = idx >> 8, c8 = (idx & 255) * 8;
        int lo, hi; if (row < 2 * CTXL) { lo = (row / CTXL) * CTXL; hi = lo + CTXL; } else { lo = 2 * CTXL + ((row - 2 * CTXL) / SEQ) * SEQ; hi = lo + SEQ; }
        f32x4 a0 = *(const f32x4*)(cb + c8), a1 = *(const f32x4*)(cb + c8 + 4);
#pragma unroll
        for (int j = 0; j < 4; ++j) { const int rr = row + j - 2;
            if (rr >= lo && rr < hi) { const u32x4 uw = *(const u32x4*)(UP + (size_t)rr * D + c8); const f32x4 w0 = *(const f32x4*)(cw + j * D + c8), w1 = *(const f32x4*)(cw + j * D + c8 + 4);
                a0 += w0 * (f32x4){bflo(uw.x), bfhi(uw.x), bflo(uw.y), bfhi(uw.y)}; a1 += w1 * (f32x4){bflo(uw.z), bfhi(uw.z), bflo(uw.w), bfhi(uw.w)}; } }
        *(u32x4*)(U + (size_t)row * D + c8) = pk8(a0, a1); }
}
__device__ __forceinline__ void r1_phase(const bf16* LA, const bf16* XI, float* CP, float* CH, int gt, int NGT) {
    for (int it = gt; it < 2 * 2 * NSEG * 256; it += NGT) { const int c8 = (it & 255) * 8; int r = it >> 8; const int s = r % NSEG; r /= NSEG; const int dir = r & 1, b = r >> 1;
        const bf16* la = LA + (size_t)dir * M * D + c8; const bf16* xi = XI + (size_t)dir * M * D + c8; const int rb = row_of(b, 32 * s);
        float P[8], H[8];
#pragma unroll
        for (int e = 0; e < 8; ++e) { P[e] = 0.f; H[e] = 0.f; }
#pragma unroll 4
        for (int i = 0; i < 32; ++i) { const int row = rb + (dir ? 31 - i : i); const u32x4 lw = *(const u32x4*)(la + (size_t)row * D), xw = *(const u32x4*)(xi + (size_t)row * D);
            const float l[8] = {bflo(lw.x), bfhi(lw.x), bflo(lw.y), bfhi(lw.y), bflo(lw.z), bfhi(lw.z), bflo(lw.w), bfhi(lw.w)}, x[8] = {bflo(xw.x), bfhi(xw.x), bflo(xw.y), bfhi(xw.y), bflo(xw.z), bfhi(xw.z), bflo(xw.w), bfhi(xw.w)};
#pragma unroll
            for (int e = 0; e < 8; ++e) { P[e] += l[e]; H[e] = __expf(l[e]) * H[e] + x[e]; } }
        const size_t o = ((size_t)(b * 2 + dir) * NSEG + s) * D + c8;
        *(f32x4*)(CP + o) = (f32x4){P[0], P[1], P[2], P[3]}; *(f32x4*)(CP + o + 4) = (f32x4){P[4], P[5], P[6], P[7]};
        *(f32x4*)(CH + o) = (f32x4){H[0], H[1], H[2], H[3]}; *(f32x4*)(CH + o + 4) = (f32x4){H[4], H[5], H[6], H[7]}; }
}
__device__ __forceinline__ void r2_phase(const float* CP, const float* CH, float* CIN, int gt, int NGT) {
    for (int it = gt; it < 2 * 2 * D; it += NGT) { const int ch = it & (D - 1), dir = (it >> 11) & 1, b = it >> 12; const size_t base = (size_t)(b * 2 + dir) * NSEG * D + ch; float h = 0.f;
#pragma unroll 8
        for (int i = 0; i < NSEG; ++i) { const int s = dir ? (i < 8 ? 7 - i : NSEG + 7 - i) : i; const size_t o = base + (size_t)s * D; CIN[o] = h; h = __expf(CP[o]) * h + CH[o]; } }
}
__device__ __forceinline__ void r3_phase(const bf16* LA, const bf16* XI, const bf16* GY, const float* CIN, bf16* HG, int G, int tid) {
    for (int it = blockIdx.x; it < 2 * NSEG; it += G) { const int b = it / NSEG, s = it % NSEG, c4 = tid * 4, rb = row_of(b, 32 * s);
        f32x4 hf[32]; f32x4 h = *(const f32x4*)(CIN + ((size_t)(b * 2 + 0) * NSEG + s) * D + c4);
#pragma unroll
        for (int i = 0; i < 32; ++i) { const size_t o = (size_t)(rb + i) * D + c4; const u32x2 lw = *(const u32x2*)(LA + o), xw = *(const u32x2*)(XI + o);
            const f32x4 l = {bflo(lw.x), bfhi(lw.x), bflo(lw.y), bfhi(lw.y)}, x = {bflo(xw.x), bfhi(xw.x), bflo(xw.y), bfhi(xw.y)};
#pragma unroll
            for (int e = 0; e < 4; ++e) h[e] = __expf(l[e]) * h[e] + x[e];
            hf[i] = h; if ((i & 7) == 7) asm volatile("" ::: "memory"); }
        h = *(const f32x4*)(CIN + ((size_t)(b * 2 + 1) * NSEG + s) * D + c4);
#pragma unroll
        for (int i = 31; i >= 0; --i) { const size_t o = (size_t)(rb + i) * D + c4; const u32x2 lw = *(const u32x2*)(LA + (size_t)M * D + o), xw = *(const u32x2*)(XI + (size_t)M * D + o), gw2 = *(const u32x2*)(GY + o);
            const f32x4 l = {bflo(lw.x), bfhi(lw.x), bflo(lw.y), bfhi(lw.y)}, x = {bflo(xw.x), bfhi(xw.x), bflo(xw.y), bfhi(xw.y)}, g = {bflo(gw2.x), bfhi(gw2.x), bflo(gw2.y), bfhi(gw2.y)};
#pragma unroll
            for (int e = 0; e < 4; ++e) h[e] = __expf(l[e]) * h[e] + x[e];
            const f32x4 y = g * (hf[i] + h); u32x2 ow; ow.x = pk2(y[0], y[1]); ow.y = pk2(y[2], y[3]); *(u32x2*)(HG + o) = ow;
            if ((i & 7) == 0) asm volatile("" ::: "memory"); } }
}
__device__ __forceinline__ void final_phase(const float* X, const float* SSQ, const float* fnorm, float* out, int gw, int NGW, int lane) {
    for (int r = gw; r < NBATCH * SEQ; r += NGW) { const int row = 2 * CTXL + r;
        float s = lane < 32 ? SSQ[(size_t)row * 32 + lane] : 0.f; s = wave_sum(s); const float rs = 1.0f / sqrtf(s * (1.0f / D) + EPS);
#pragma unroll
        for (int j = 0; j < 8; ++j) { const int k = lane * 4 + 256 * j; *(f32x4*)(out + (size_t)r * D + k) = *(const f32x4*)(X + (size_t)row * D + k) * rs * *(const f32x4*)(fnorm + k); } }
}

constexpr int PH_P0 = 0, PH_P1 = 1, PH_PAIR0 = 2, PH_PER_PAIR = 15, PH_FINAL = PH_PAIR0 + 2 * PH_PER_PAIR, NPHASE = PH_FINAL + 1;
struct Args { const float* in[22]; float* out; unsigned char* ws; int ph_lo, ph_hi, li, pad; };
__global__ void __launch_bounds__(NTHR, 2) hyb_fwd(Args args) {
    extern __shared__ __attribute__((aligned(16))) unsigned char lds_raw[];
    LAS unsigned char* lds = (LAS unsigned char*)lds_raw;
    volatile LAS unsigned* MISC = (volatile LAS unsigned*)(lds + MISC_OFF);
    const int G = gridDim.x, NGW = G * NWAVES, NGT = G * NTHR;
#define TIDS() int tid = threadIdx.x; asm volatile("" : "+v"(tid)); const int lane = tid & 63, wave = __builtin_amdgcn_readfirstlane(tid >> 6), gw = blockIdx.x * NWAVES + wave, gt = blockIdx.x * NTHR + tid; (void)lane; (void)gw; (void)gt
    const __attribute__((address_space(4))) Args* ap = (const __attribute__((address_space(4))) Args*)__builtin_amdgcn_kernarg_segment_ptr(); asm volatile("" : "+s"(ap));
#define INP(i) (ap->in[i])
#define WSP(T, off) ((T*)(ap->ws + (off)))
#define in_x INP(0)
#define in_c INP(1)
#define in_ctx INP(2)
#define in_cctx INP(3)
#define w_mod INP(4)
#define b_mod INP(5)
#define norm1 INP(6)
#define norm2 INP(7)
#define a_w_in INP(8)
#define a_lb INP(9)
#define a_onorm INP(10)
#define a_w_out INP(11)
#define b_w_in INP(12)
#define b_conv_w INP(13)
#define b_conv_b INP(14)
#define b_gate_w INP(15)
#define b_gate_b INP(16)
#define b_lambda INP(17)
#define b_w_out INP(18)
#define mlp_w1 INP(19)
#define mlp_w2 INP(20)
#define fnorm INP(21)
#define MOD WSP(float, WS_MOD)
#define BIAS1 WSP(float, WS_BIAS1)
#define BIAS2 WSP(float, WS_BIAS2)
#define LB WSP(float, WS_LB)
#define CL WSP(float, WS_CL)
#define GM WSP(float, WS_GM)
#define SSQ WSP(float, WS_SSQ)
#define CP WSP(float, WS_CP)
#define CH WSP(float, WS_CH)
#define CIN WSP(float, WS_CIN)
#define Wb WSP(bf16, WS_W)
#define X WSP(float, WS_X)
#define XM WSP(bf16, WS_XM)
#define R0 WSP(bf16, WS_R0)
#define R1 WSP(bf16, WS_R1)
#define R2 WSP(bf16, WS_R2)
#define R3 WSP(bf16, WS_R3)
#define LF WSP(float, WS_R4)
#define LA WSP(bf16, WS_R4)
#define XI (WSP(bf16, WS_R4) + (size_t)2 * M * D)
#define HB WSP(bf16, WS_R4)
#define OB WSP(bf16, WS_R5)
    unsigned* ctl = (unsigned*)(ap->ws + WS_CTL);

    for (int u = threadIdx.x; u < (LDS_BYTES - LDSCTL_OFF) / 4; u += NTHR) ((LAS unsigned*)(lds + LDSCTL_OFF))[u] = 0u;
    __syncthreads();
    XcdBarrier bar = xcd_barrier_post(ctl + CW_BAR + ap->li * XCD_BAR_WORDS, MISC + 8);
    const int lo = ap->ph_lo, hi = ap->ph_hi;
#ifndef PHMASK
#define PHMASK 0xFFFFFFFFull
#endif
#define EN(b) (((PHMASK) >> (b)) & 1ull)
#define IN(k) (lo <= (k) && (k) < hi)
#define SEAM(k) do { if ((k) + 1 < hi) xcd_barrier(bar); } while (0)

    if (EN(0) && IN(PH_P0)) { TIDS();
        p0_mod(lds, in_c, in_cctx, w_mod, b_mod, MOD, G, tid);
        p0_tables(a_lb, b_lambda, LB, CL, gt, NGT);
        p0_weights(lds, a_w_in, a_w_out, b_w_in, b_gate_w, b_w_out, mlp_w1, mlp_w2, Wb, gw, NGW, lane, wave);
        SEAM(PH_P0);
    }
    if (EN(1) && IN(PH_P1)) { TIDS();
        p1_phase(in_x, in_ctx, norm1, norm2, MOD, GM, X, XM, SSQ, Wb, BIAS1, BIAS2, gw, NGW, gt, NGT, lane);
        SEAM(PH_P1);
    }
    for (int lp = 0; lp < 2; ++lp) {
        const int pb = PH_PAIR0 + lp * PH_PER_PAIR, la = 2 * lp, lb = 2 * lp + 1;
        if (EN(2) && IN(pb + 0)) {
            pg8::Gemm g{XM, Wb + W_INA + (size_t)lp * NA_IN * D, M, NA_IN, D, D}; pg8::StaticOrder S; S.init(M, NA_IN, G, (int)blockIdx.x);
            pg8::EpiA1 E{SSQ, BIAS1 + (size_t)la * 3 * 10240, LB + (size_t)lp * 2 * D, R0, R1, R2, LF};
            pg8::gemm_phase<pg8::EpiA1, pg8::StaticOrder, PG8_ALIGN, PG8_SP2>(lds + RING_OFF, g, S, E);
            SEAM(pb + 0);
        }
        if (EN(3) && IN(pb + 1)) { TIDS(); hgrn_scan_phase(lds, R0, R1, LF, OB, G, tid); SEAM(pb + 1); }
        if (EN(4) && IN(pb + 2)) { TIDS(); a3_phase(OB, R2, a_onorm + (size_t)lp * D, R3, gw, NGW, lane); SEAM(pb + 2); }
        if (EN(5) && IN(pb + 3)) {
            pg8::Gemm g{R3, Wb + W_OUTA + (size_t)lp * D * D, M, D, D, D}; pg8::StaticOrder S; S.init(M, D, G, (int)blockIdx.x);
            pg8::EpiRes E{X, MOD + (size_t)la * 3 * NMOD + 2 * D, GM + (size_t)(la * 2 + 1) * 3 * D, XM, SSQ};
            pg8::gemm_phase<pg8::EpiRes, pg8::StaticOrder, PG8_ALIGN, PG8_SP2>(lds + RING_OFF, g, S, E);
            SEAM(pb + 3);
        }
        if (EN(6) && IN(pb + 4)) {
            pg8::Gemm g{XM, Wb + W_1 + (size_t)la * FF * D, M, FF, D, D}; pg8::StaticOrder S; S.init(M, FF, G, (int)blockIdx.x);
            pg8::EpiMlp1 E{SSQ, BIAS2 + (size_t)la * 3 * FF, HB};
            pg8::gemm_phase<pg8::EpiMlp1, pg8::StaticOrder, PG8_ALIGN, PG8_SP2>(lds + RING_OFF, g, S, E);
            SEAM(pb + 4);
        }
        if (EN(7) && IN(pb + 5)) {
            pg8::Gemm g{HB, Wb + W_2 + (size_t)la * D * FF, M, D, FF, FF}; pg8::StaticOrder S; S.init(M, D, G, (int)blockIdx.x);
            pg8::EpiRes E{X, MOD + (size_t)la * 3 * NMOD + 5 * D, GM + (size_t)(lb * 2 + 0) * 3 * D, XM, SSQ};
            pg8::gemm_phase<pg8::EpiRes, pg8::StaticOrder, PG8_ALIGN, PG8_SP2>(lds + RING_OFF, g, S, E);
            SEAM(pb + 5);
        }
        if (EN(8) && IN(pb + 6)) {
            pg8::Gemm g{XM, Wb + W_INB + (size_t)lp * NB_IN * D, M, NB_IN, D, D}; pg8::StaticOrder S; S.init(M, NB_IN, G, (int)blockIdx.x);
            pg8::EpiB1 E{SSQ, BIAS1 + (size_t)lb * 3 * 10240, R0, R1};
            pg8::gemm_phase<pg8::EpiB1, pg8::StaticOrder, PG8_ALIGN, PG8_SP2>(lds + RING_OFF, g, S, E);
            SEAM(pb + 6);
        }
        if (EN(9) && IN(pb + 7)) { TIDS(); conv_phase(R1, b_conv_w + (size_t)lp * 4 * D, b_conv_b + (size_t)lp * D, R2, gt, NGT); SEAM(pb + 7); }
        if (EN(10) && IN(pb + 8)) {
            pg8::Gemm g{R2, Wb + W_GATE + (size_t)lp * 32 * 65536, M, 32 * 256, 256, D}; pg8::GateOrder S; S.init(M, 32 * 256, G, (int)blockIdx.x);
            pg8::EpiGate E{b_gate_b + (size_t)lp * 4 * D, CL + (size_t)lp * 2 * D, R2, LA, XI};
            pg8::gemm_phase<pg8::EpiGate, pg8::GateOrder, PG8_ALIGN, PG8_SP2>(lds + RING_OFF, g, S, E);
            SEAM(pb + 8);
        }
        if (EN(11) && IN(pb + 9)) { TIDS(); r1_phase(LA, XI, CP, CH, gt, NGT); SEAM(pb + 9); }
        if (EN(12) && IN(pb + 10)) { TIDS(); r2_phase(CP, CH, CIN, gt, NGT); SEAM(pb + 10); }
        if (EN(13) && IN(pb + 11)) { TIDS(); r3_phase(LA, XI, R0, CIN, R3, G, tid); SEAM(pb + 11); }
        if (EN(14) && IN(pb + 12)) {
            pg8::Gemm g{R3, Wb + W_OUTB + (size_t)lp * D * D, M, D, D, D}; pg8::StaticOrder S; S.init(M, D, G, (int)blockIdx.x);
            pg8::EpiRes E{X, MOD + (size_t)lb * 3 * NMOD + 2 * D, GM + (size_t)(lb * 2 + 1) * 3 * D, XM, SSQ};
            pg8::gemm_phase<pg8::EpiRes, pg8::StaticOrder, PG8_ALIGN, PG8_SP2>(lds + RING_OFF, g, S, E);
            SEAM(pb + 12);
        }
        if (EN(15) && IN(pb + 13)) {
            pg8::Gemm g{XM, Wb + W_1 + (size_t)lb * FF * D, M, FF, D, D}; pg8::StaticOrder S; S.init(M, FF, G, (int)blockIdx.x);
            pg8::EpiMlp1 E{SSQ, BIAS2 + (size_t)lb * 3 * FF, HB};
            pg8::gemm_phase<pg8::EpiMlp1, pg8::StaticOrder, PG8_ALIGN, PG8_SP2>(lds + RING_OFF, g, S, E);
            SEAM(pb + 13);
        }
        if (EN(16) && IN(pb + 14)) {
            const int ln = lb + 1 < DEPTH ? lb + 1 : lb;
            pg8::Gemm g{HB, Wb + W_2 + (size_t)lb * D * FF, M, D, FF, FF}; pg8::StaticOrder S; S.init(M, D, G, (int)blockIdx.x);
            pg8::EpiRes E{X, MOD + (size_t)lb * 3 * NMOD + 5 * D, GM + (size_t)(ln * 2 + 0) * 3 * D, XM, SSQ};
            pg8::gemm_phase<pg8::EpiRes, pg8::StaticOrder, PG8_ALIGN, PG8_SP2>(lds + RING_OFF, g, S, E);
            SEAM(pb + 14);
        }
    }
    if (EN(17) && IN(PH_FINAL)) { TIDS(); final_phase(X, SSQ, fnorm, ap->out, gw, NGW, lane); }
#undef IN
#undef SEAM
}

extern "C" void kernel_launch(void* const* d_in, const int* in_sizes, int n_in, void* d_out, int out_size, void* d_ws, size_t ws_size, hipStream_t stream) {
    static int grid = 0;
    if (grid == 0) {
        if (n_in != 22 || out_size != NBATCH * SEQ * D || ws_size < WS_END) { fprintf(stderr, "kernel_launch: unexpected shapes (n_in %d, out %d, ws %zu); nothing launched\n", n_in, out_size, ws_size); grid = -1; return; }
        int dev = 0, cus = 0, per_cu = 0;
        if (hipGetDevice(&dev) != hipSuccess || hipDeviceGetAttribute(&cus, hipDeviceAttributeMultiprocessorCount, dev) != hipSuccess) { grid = -1; return; }
        if (hipFuncSetAttribute((const void*)hyb_fwd, hipFuncAttributeMaxDynamicSharedMemorySize, LDS_BYTES) != hipSuccess) { fprintf(stderr, "kernel_launch: hipFuncSetAttribute failed\n"); grid = -1; return; }
        if (hipOccupancyMaxActiveBlocksPerMultiprocessor(&per_cu, (const void*)hyb_fwd, NTHR, LDS_BYTES) != hipSuccess || per_cu < 1) fprintf(stderr, "kernel_launch: occupancy query reports %d\n", per_cu);
        (void)hipGetLastError();
        grid = cus;
    }
    if (grid < 0) return;
    if (hipMemsetAsync((char*)d_ws + WS_CTL, 0, CTL_ZERO_BYTES, stream) != hipSuccess) return;
    Args a{};
    for (int i = 0; i < 22; ++i) a.in[i] = (const float*)d_in[i];
    a.out = (float*)d_out; a.ws = (unsigned char*)d_ws;
#if MK_ONE_LAUNCH
    a.ph_lo = 0; a.ph_hi = NPHASE; a.li = 0;
    hipLaunchKernelGGL(hyb_fwd, dim3(grid), dim3(NTHR), LDS_BYTES, stream, a);
#else
    for (int k = 0; k < NPHASE; ++k) { a.ph_lo = k; a.ph_hi = k + 1; a.li = k;
        hipLaunchKernelGGL(hyb_fwd, dim3(grid), dim3(NTHR), LDS_BYTES, stream, a); }
#endif
}
```

```cpp
#include <hip/hip_runtime.h>
#include <cstdio>
#include <cstdint>
namespace pg8 {
#define PG8_LAS __attribute__((address_space(3)))
typedef unsigned short bf16_t;
typedef short bf16x8 __attribute__((ext_vector_type(8)));
typedef float f32x4 __attribute__((ext_vector_type(4)));
typedef unsigned u32x4 __attribute__((ext_vector_type(4)));
constexpr int BM = 256, BK = 64, HALF = 128, HTB = HALF * BK * 2  , STAGE_BYTES = 8 * HTB, NXCD = 8, WGM = 8;

__host__ __device__ __forceinline__ int lds_byte(int r, int c) { const int st = (r >> 4) * 2 + (c >> 5), rr = r & 15, cc = c & 31, ob = rr * 64 + cc * 2; return st * 1024 + (ob ^ (((ob >> 9) & 1) << 5)); }
__host__ __device__ __forceinline__ void stage_rc(int b, int& R, int& C) { const int st = b / 1024, sb = b % 1024, swz = sb ^ (((sb >> 9) & 1) << 5); R = (st >> 1) * 16 + swz / 64; C = (st & 1) * 32 + (swz % 64) / 2; }
__host__ __device__ __forceinline__ int perm32(int rho) { const int n = rho >> 4, i = rho & 15; return 8 * (i >> 2) + 4 * n + (i & 3); }

struct Unit { int pm, pn; };
struct Gemm { const bf16_t* A; const bf16_t* Bt; int M, N, K, lda; };

struct StaticOrder {
    int nM, nN, nwg, G, c, pm0;
    __host__ __device__ void init(int M, int N, int G_, int c_, int pm0_ = 0) { pm0 = pm0_; nM = M / BM - pm0_; nN = N / BM; nwg = nM * nN; G = G_; c = c_; }
    __host__ __device__ bool next(int i, Unit& u) const {
        const long L = (long)i * G + c; if (L >= nwg) return false;
        int wgid = (int)L; { const int q = nwg / NXCD, r = nwg % NXCD, xcd = wgid % NXCD, off = wgid / NXCD; wgid = (xcd < r ? xcd * (q + 1) : r * (q + 1) + (xcd - r) * q) + off; }
        const int nig = WGM * nN, gid = wgid / nig, fm = gid * WGM, gsz = (nM - fm) < WGM ? (nM - fm) : WGM;
        u.pm = pm0 + fm + ((wgid % nig) % gsz); u.pn = (wgid % nig) / gsz; return true;
    }
    __device__ __forceinline__ void a_ready(const Unit&) const {}
    __device__ __forceinline__ int a_koff(const Unit&) const { return 0; }
    __device__ __forceinline__ void done(const Unit&) const {}
};


typedef float f32x2 __attribute__((ext_vector_type(2)));
typedef __bf16 bf16x2v __attribute__((ext_vector_type(2)));
typedef unsigned u32x2 __attribute__((ext_vector_type(2)));
__device__ __forceinline__ unsigned pk2(float lo, float hi) { f32x2 v = {lo, hi}; bf16x2v b = __builtin_convertvector(v, bf16x2v); return __builtin_bit_cast(unsigned, b); }
__device__ __forceinline__ u32x4 pk8(const f32x4& a, const f32x4& b) { u32x4 w; w.x = pk2(a[0], a[1]); w.y = pk2(a[2], a[3]); w.z = pk2(b[0], b[1]); w.w = pk2(b[2], b[3]); return w; }
__device__ __forceinline__ float bflo(unsigned w) { return __uint_as_float(w << 16); }
__device__ __forceinline__ float bfhi(unsigned w) { return __uint_as_float(w & 0xffff0000u); }
constexpr int ROWS = 16896, DM = 2048;
__device__ __forceinline__ int grp_of_pm(int pm) { return pm < 2 ? 0 : (pm < 34 ? 1 : 2); }
__device__ __forceinline__ float sigmoidf_(float z) { return __builtin_amdgcn_rcpf(1.0f + __expf(-z)); }
__device__ __forceinline__ float one_minus_exp(float x) {
    const float p = -x * (1.0f + x * (0.5f + x * (0.16666667f + x * (0.041666668f + x * (0.0083333338f + x * 0.0013888889f)))));
    return x < -0.25f ? 1.0f - __expf(x) : fmaxf(p, 0.f);
}
__device__ __forceinline__ float row_rstd(const float* ssq, int row, int fq) {
    const f32x4 a = *(const f32x4*)(ssq + (size_t)row * 32 + fq * 8), b = *(const f32x4*)(ssq + (size_t)row * 32 + fq * 8 + 4);
    float s = ((a[0] + a[1]) + (a[2] + a[3])) + ((b[0] + b[1]) + (b[2] + b[3]));
    s += __shfl_xor(s, 16); s += __shfl_xor(s, 32);
    return 1.0f / sqrtf(s * (1.0f / 2048.0f) + 1e-6f);
}

constexpr int TAB_OFF = 132096, TAB_BYTES = 4096;
__device__ __forceinline__ void prep_rstd(PG8_LAS unsigned char* tab, const float* ssq, int pm, int tid) {
    if (tid < 256) { const float* p = ssq + ((size_t)pm * BM + tid) * 32; f32x4 a[8];
#pragma unroll
        for (int j = 0; j < 8; ++j) a[j] = *(const f32x4*)(p + 4 * j);
        float s = 0.f;
#pragma unroll
        for (int j = 0; j < 8; ++j) s += (a[j][0] + a[j][1]) + (a[j][2] + a[j][3]);
        ((PG8_LAS float*)tab)[tid] = 1.0f / sqrtf(s * (1.0f / 2048.0f) + 1e-6f); }
}
__device__ __forceinline__ void prep_vecs(PG8_LAS unsigned char* tab, const float* v0, const float* v1, const float* v2, int tid) {
    if (tid >= 256) { const int j = tid - 256; PG8_LAS float* t = (PG8_LAS float*)(tab + 1024);
        const float a = v0 ? v0[j] : 0.f, b = v1 ? v1[j] : 0.f, c = v2 ? v2[j] : 0.f; t[j] = a; t[256 + j] = b; t[512 + j] = c; }
}
__device__ __forceinline__ float tab_rstd(const PG8_LAS unsigned char* tab, int r) { return ((const PG8_LAS float*)tab)[r]; }
__device__ __forceinline__ f32x4 tab_vec(const PG8_LAS unsigned char* tab, int v, int j) { return *(const PG8_LAS f32x4*)(tab + 1024 + v * 1024 + j * 4); }
template <int CTRL> __device__ __forceinline__ float dpp_f(float v) { return __builtin_bit_cast(float, __builtin_amdgcn_update_dpp(0x3f800000, __builtin_bit_cast(int, v), CTRL, 0xf, 0xf, false)); }
__device__ __forceinline__ float bperm_f(int byte_idx, float v) { return __builtin_bit_cast(float, __builtin_amdgcn_ds_bpermute(byte_idx, __builtin_bit_cast(int, v))); }
struct EpiA1 {
    static constexpr bool PERM = true, AFTER_DRAIN = false;
    const float* ssq; const float* bias; const float* lb; bf16_t* Q; bf16_t* V; bf16_t* SG; bf16_t* EB; bf16_t* KT; bf16_t* KH; float* DEC;
    __device__ __forceinline__ void prep(const Unit& u, PG8_LAS unsigned char* tab, int tid) const { prep_rstd(tab, ssq, u.pm, tid);
        prep_vecs(tab, bias + grp_of_pm(u.pm) * 10240 + u.pn * BM, (u.pn >> 3) >= 3 ? lb + ((u.pn >> 3) - 3) * DM + (u.pn & 7) * BM : nullptr, nullptr, tid); }
    __device__ __forceinline__ void operator()(const f32x4 (&acc)[2][2][4][2], const Unit& u, int wr, int wc, int fr0, int fq0, const PG8_LAS unsigned char* tab) const {
        int fr = fr0, fq = fq0; asm volatile("" : "+v"(fr), "+v"(fq));
        const int row0 = u.pm * BM + wr * 64 + fr, kind = u.pn >> 3, ct = (u.pn & 7) * BM + wc * 32 + 8 * fq, bcol = u.pn * BM + wc * 32 + 8 * fq;
        const int rl0 = wr * 64 + fr, cl0 = wc * 32 + 8 * fq; (void)bcol;
        f32x4 bv[2][2];
#pragma unroll
        for (int bj = 0; bj < 2; ++bj)
#pragma unroll
            for (int n = 0; n < 2; ++n) bv[bj][n] = tab_vec(tab, 0, cl0 + bj * HALF + 4 * n);
        if (kind < 3) {
#pragma unroll
            for (int ai = 0; ai < 2; ++ai)
#pragma unroll
                for (int m = 0; m < 4; ++m) { const int row = row0 + ai * HALF + m * 16; const float rs = tab_rstd(tab, rl0 + ai * HALF + m * 16);
#pragma unroll
                    for (int bj = 0; bj < 2; ++bj) { f32x4 v0 = acc[ai][bj][m][0] * rs + bv[bj][0], v1 = acc[ai][bj][m][1] * rs + bv[bj][1];
                        const size_t off = (size_t)row * DM + ct + bj * HALF;
                        if (kind == 0) { *(u32x4*)(Q + off) = pk8(v0, v1); }
                        else if (kind == 1) { *(u32x4*)(V + off) = pk8(v0, v1); }
                        else {
#pragma unroll
                            for (int e = 0; e < 4; ++e) { v0[e] = v0[e] * sigmoidf_(v0[e]); v1[e] = v1[e] * sigmoidf_(v1[e]); }
                            *(u32x4*)(SG + off) = pk8(v0, v1); } } }
        } else {
            const int d = kind - 3; const size_t dofs = (size_t)d * ROWS * DM;
            const int bidx = ((fq * 16) | (d == 0 ? 15 : 0)) * 4;
#pragma unroll
            for (int ai = 0; ai < 2; ++ai)
#pragma unroll
                for (int mp = 0; mp < 2; ++mp) { const int rowA = row0 + ai * HALF + mp * 32, rowB = rowA + 16; const float rsA = tab_rstd(tab, rl0 + ai * HALF + mp * 32), rsB = tab_rstd(tab, rl0 + ai * HALF + mp * 32 + 16);
#pragma unroll
                    for (int bj = 0; bj < 2; ++bj)
#pragma unroll
                        for (int n = 0; n < 2; ++n) { const f32x4 lbv = tab_vec(tab, 1, cl0 + bj * HALF + 4 * n); f32x4 ebA, ktA, khA, ebB, ktB, khB, dcv;
#pragma unroll
                            for (int e = 0; e < 4; ++e) {
                                const float zA = acc[ai][bj][2 * mp][n][e] * rsA + bv[bj][n][e], zB = acc[ai][bj][2 * mp + 1][n][e] * rsB + bv[bj][n][e];
                                const float eA = __expf(-fabsf(zA)), sA = (zA >= 0.f ? 1.0f : eA) * __builtin_amdgcn_rcpf(1.0f + eA), eB = __expf(-fabsf(zB)), sB = (zB >= 0.f ? 1.0f : eB) * __builtin_amdgcn_rcpf(1.0f + eB), l = lbv[e];
                                const float fA = fmaxf(l + (1.0f - l) * sA, 1e-35f), fB = fmaxf(l + (1.0f - l) * sB, 1e-35f);
                                float pA = fA, pB = fB, EA, EBv, dc;
                                if (d == 0) {
                                    pA *= dpp_f<0x111>(pA); pB *= dpp_f<0x111>(pB); pA *= dpp_f<0x112>(pA); pB *= dpp_f<0x112>(pB); pA *= dpp_f<0x114>(pA); pB *= dpp_f<0x114>(pB); pA *= dpp_f<0x118>(pA); pB *= dpp_f<0x118>(pB);
                                    const float totA = bperm_f(bidx, pA), totB = bperm_f(bidx, pB); EA = pA; EBv = pB * totA; dc = totA * totB;
                                } else {
                                    pA *= dpp_f<0x101>(pA); pB *= dpp_f<0x101>(pB); pA *= dpp_f<0x102>(pA); pB *= dpp_f<0x102>(pB); pA *= dpp_f<0x104>(pA); pB *= dpp_f<0x104>(pB); pA *= dpp_f<0x108>(pA); pB *= dpp_f<0x108>(pB);
                                    const float totA = bperm_f(bidx, pA), totB = bperm_f(bidx, pB); EBv = pB; EA = pA * totB; dc = totA * totB;
                                }
                                const float kA_ = (1.0f - fA) * __builtin_amdgcn_rcpf(EA), kB_ = (1.0f - fB) * __builtin_amdgcn_rcpf(EBv);
                                ebA[e] = EA; ktA[e] = kA_; khA[e] = kA_ * dc; ebB[e] = EBv; ktB[e] = kB_; khB[e] = kB_ * dc; dcv[e] = dc; }
                            const size_t offA = dofs + (size_t)rowA * DM + ct + bj * HALF + 4 * n, offB = offA + (size_t)16 * DM;
                            u32x2 w_;
                            w_.x = pk2(ebA[0], ebA[1]); w_.y = pk2(ebA[2], ebA[3]); *(u32x2*)(EB + offA) = w_; w_.x = pk2(ktA[0], ktA[1]); w_.y = pk2(ktA[2], ktA[3]); *(u32x2*)(KT + offA) = w_; w_.x = pk2(khA[0], khA[1]); w_.y = pk2(khA[2], khA[3]); *(u32x2*)(KH + offA) = w_;
                            w_.x = pk2(ebB[0], ebB[1]); w_.y = pk2(ebB[2], ebB[3]); *(u32x2*)(EB + offB) = w_; w_.x = pk2(ktB[0], ktB[1]); w_.y = pk2(ktB[2], ktB[3]); *(u32x2*)(KT + offB) = w_; w_.x = pk2(khB[0], khB[1]); w_.y = pk2(khB[2], khB[3]); *(u32x2*)(KH + offB) = w_;
                            if (fr == 0) *(f32x4*)(DEC + ((size_t)d * (ROWS / 32) + (rowA >> 5)) * DM + ct + bj * HALF + 4 * n) = dcv;
                            __builtin_amdgcn_sched_barrier(0); } }
        }
    }
};
struct EpiRes {
    static constexpr bool PERM = true, AFTER_DRAIN = false;
    float* X; const float* gate; const float* gm; bf16_t* XM; float* ssq;
    __device__ __forceinline__ void prep(const Unit& u, PG8_LAS unsigned char* tab, int tid) const { const int grp = grp_of_pm(u.pm); prep_vecs(tab, gate + grp * 12288 + u.pn * BM, gm + grp * DM + u.pn * BM, nullptr, tid); }
    __device__ __forceinline__ void operator()(const f32x4 (&acc)[2][2][4][2], const Unit& u, int wr, int wc, int fr0, int fq0, const PG8_LAS unsigned char* tab) const {
        int fr = fr0, fq = fq0; asm volatile("" : "+v"(fr), "+v"(fq));
        const int row0 = u.pm * BM + wr * 64 + fr, col0 = u.pn * BM + wc * 32 + 8 * fq, cl0 = wc * 32 + 8 * fq;
        f32x4 gv[2][2], mv[2][2];
#pragma unroll
        for (int bj = 0; bj < 2; ++bj)
#pragma unroll
            for (int n = 0; n < 2; ++n) { gv[bj][n] = tab_vec(tab, 0, cl0 + bj * HALF + 4 * n); mv[bj][n] = tab_vec(tab, 1, cl0 + bj * HALF + 4 * n); }
        f32x4 xa[2][2], xb[2][2];
#define ER_LOAD(dst, g_) do { const int row_ = row0 + ((g_) >> 2) * HALF + ((g_) & 3) * 16; _Pragma("unroll") for (int bj = 0; bj < 2; ++bj) { const float* xp_ = X + (size_t)row_ * DM + col0 + bj * HALF; dst[bj][0] = *(const f32x4*)xp_; dst[bj][1] = *(const f32x4*)(xp_ + 4); } } while (0)
#define ER_DO(src, g_) do { const int ai_ = (g_) >> 2, m_ = (g_) & 3, row_ = row0 + ai_ * HALF + m_ * 16; float ss = 0.f; \
            _Pragma("unroll") for (int bj = 0; bj < 2; ++bj) { float* xp_ = X + (size_t)row_ * DM + col0 + bj * HALF; \
                const f32x4 n0 = src[bj][0] + gv[bj][0] * acc[ai_][bj][m_][0], n1 = src[bj][1] + gv[bj][1] * acc[ai_][bj][m_][1]; \
                *(f32x4*)xp_ = n0; *(f32x4*)(xp_ + 4) = n1; \
                ss += ((n0[0] * n0[0] + n0[1] * n0[1]) + (n0[2] * n0[2] + n0[3] * n0[3])) + ((n1[0] * n1[0] + n1[1] * n1[1]) + (n1[2] * n1[2] + n1[3] * n1[3])); \
                *(u32x4*)(XM + (size_t)row_ * DM + col0 + bj * HALF) = pk8(n0 * mv[bj][0], n1 * mv[bj][1]); } \
            ss += __shfl_xor(ss, 16); ss += __shfl_xor(ss, 32); \
            if (fq == 0) ssq[(size_t)row_ * 32 + u.pn * 4 + wc] = ss; } while (0)
        ER_LOAD(xa, 0);
        ER_LOAD(xb, 1); ER_DO(xa, 0); ER_LOAD(xa, 2); ER_DO(xb, 1); ER_LOAD(xb, 3); ER_DO(xa, 2); ER_LOAD(xa, 4); ER_DO(xb, 3);
        ER_LOAD(xb, 5); ER_DO(xa, 4); ER_LOAD(xa, 6); ER_DO(xb, 5); ER_LOAD(xb, 7); ER_DO(xa, 6); ER_DO(xb, 7);
#undef ER_LOAD
#undef ER_DO
    }
};
struct EpiMlp1 {
    static constexpr bool PERM = true, AFTER_DRAIN = false;
    const float* ssq; const float* bias; bf16_t* H;
    __device__ __forceinline__ void prep(const Unit& u, PG8_LAS unsigned char* tab, int tid) const { prep_rstd(tab, ssq, u.pm, tid); prep_vecs(tab, bias + grp_of_pm(u.pm) * 8192 + u.pn * BM, nullptr, nullptr, tid); }
    __device__ __forceinline__ void operator()(const f32x4 (&acc)[2][2][4][2], const Unit& u, int wr, int wc, int fr0, int fq0, const PG8_LAS unsigned char* tab) const {
        int fr = fr0, fq = fq0; asm volatile("" : "+v"(fr), "+v"(fq));
        const int row0 = u.pm * BM + wr * 64 + fr, col0 = u.pn * BM + wc * 32 + 8 * fq;
        const int rl0 = wr * 64 + fr, cl0 = wc * 32 + 8 * fq;
        f32x4 bv[2][2];
#pragma unroll
        for (int bj = 0; bj < 2; ++bj)
#pragma unroll
            for (int n = 0; n < 2; ++n) bv[bj][n] = tab_vec(tab, 0, cl0 + bj * HALF + 4 * n);
#pragma unroll
        for (int ai = 0; ai < 2; ++ai)
#pragma unroll
            for (int m = 0; m < 4; ++m) { const int row = row0 + ai * HALF + m * 16; const float rs = tab_rstd(tab, rl0 + ai * HALF + m * 16);
#pragma unroll
                for (int bj = 0; bj < 2; ++bj) { f32x4 v0 = acc[ai][bj][m][0] * rs + bv[bj][0], v1 = acc[ai][bj][m][1] * rs + bv[bj][1];
#pragma unroll
                    for (int e = 0; e < 4; ++e) { const float a = fmaxf(v0[e], 0.f), b = fmaxf(v1[e], 0.f); v0[e] = a * a; v1[e] = b * b; }
                    *(u32x4*)(H + (size_t)row * 8192 + col0 + bj * HALF) = pk8(v0, v1); } }
    }
};
struct EpiB1 {
    static constexpr bool PERM = true, AFTER_DRAIN = false;
    const float* ssq; const float* bias; bf16_t* GY; bf16_t* UP;
    __device__ __forceinline__ void prep(const Unit& u, PG8_LAS unsigned char* tab, int tid) const { prep_rstd(tab, ssq, u.pm, tid); prep_vecs(tab, bias + grp_of_pm(u.pm) * 10240 + u.pn * BM, nullptr, nullptr, tid); }
    __device__ __forceinline__ void operator()(const f32x4 (&acc)[2][2][4][2], const Unit& u, int wr, int wc, int fr0, int fq0, const PG8_LAS unsigned char* tab) const {
        int fr = fr0, fq = fq0; asm volatile("" : "+v"(fr), "+v"(fq));
        const int row0 = u.pm * BM + wr * 64 + fr, kind = u.pn >> 3, ct = (u.pn & 7) * BM + wc * 32 + 8 * fq, bcol = u.pn * BM + wc * 32 + 8 * fq;
        const int rl0 = wr * 64 + fr, cl0 = wc * 32 + 8 * fq; (void)bcol;
        f32x4 bv[2][2];
#pragma unroll
        for (int bj = 0; bj < 2; ++bj)
#pragma unroll
            for (int n = 0; n < 2; ++n) bv[bj][n] = tab_vec(tab, 0, cl0 + bj * HALF + 4 * n);
#pragma unroll
        for (int ai = 0; ai < 2; ++ai)
#pragma unroll
            for (int m = 0; m < 4; ++m) { const int row = row0 + ai * HALF + m * 16; const float rs = tab_rstd(tab, rl0 + ai * HALF + m * 16);
#pragma unroll
                for (int bj = 0; bj < 2; ++bj) { f32x4 v0 = acc[ai][bj][m][0] * rs + bv[bj][0], v1 = acc[ai][bj][m][1] * rs + bv[bj][1];
                    const size_t off = (size_t)row * DM + ct + bj * HALF;
                    if (kind == 0) {
#pragma unroll
                        for (int e = 0; e < 4; ++e) { { const float y = v0[e]; v0[e] = y * sigmoidf_(1.5957691216f * (y + 0.044715f * y * y * y)); }
                                                      { const float y = v1[e]; v1[e] = y * sigmoidf_(1.5957691216f * (y + 0.044715f * y * y * y)); } }
                        *(u32x4*)(GY + off) = pk8(v0, v1); }
                    else *(u32x4*)(UP + off) = pk8(v0, v1); } }
    }
};
struct EpiGate {
    static constexpr bool PERM = true, AFTER_DRAIN = false;
    const float* gb; const float* cl; const bf16_t* U; bf16_t* LA; bf16_t* XI;
    __device__ __forceinline__ void prep(const Unit& u, PG8_LAS unsigned char* tab, int tid) const {
        if (tid >= 256) { const int j = tid - 256, d = u.pn >> 4, c0 = (u.pn & 15) * HALF; PG8_LAS float* t = (PG8_LAS float*)(tab + 1024);
            t[j] = gb[(d * 2 + (j >> 7)) * DM + c0 + (j & 127)]; t[256 + j] = cl[d * DM + c0 + (j & 127)]; } }
    __device__ __forceinline__ void operator()(const f32x4 (&acc)[2][2][4][2], const Unit& u, int wr, int wc, int fr0, int fq0, const PG8_LAS unsigned char* tab) const {
        int fr = fr0, fq = fq0; asm volatile("" : "+v"(fr), "+v"(fq));
        const int row0 = u.pm * BM + wr * 64 + fr, d = u.pn >> 4, ch0 = (u.pn & 15) * HALF + wc * 32 + 8 * fq, cl0 = wc * 32 + 8 * fq;
        f32x4 br[2], bi[2], cv[2];
#pragma unroll
        for (int n = 0; n < 2; ++n) { br[n] = tab_vec(tab, 0, cl0 + 4 * n); bi[n] = tab_vec(tab, 0, HALF + cl0 + 4 * n); cv[n] = tab_vec(tab, 1, cl0 + 4 * n); }
        u32x4 ua, ub;
#define EG_LOAD(dst, g_) dst = *(const u32x4*)(U + (size_t)(row0 + ((g_) >> 2) * HALF + ((g_) & 3) * 16) * DM + ch0)
#define EG_DO(uw, g_) do { const int ai_ = (g_) >> 2, m_ = (g_) & 3, row_ = row0 + ai_ * HALF + m_ * 16; \
            const float uf[8] = {bflo(uw.x), bfhi(uw.x), bflo(uw.y), bfhi(uw.y), bflo(uw.z), bfhi(uw.z), bflo(uw.w), bfhi(uw.w)}; f32x4 la[2], xi[2]; \
            _Pragma("unroll") for (int n = 0; n < 2; ++n) _Pragma("unroll") for (int e = 0; e < 4; ++e) { const float r = sigmoidf_(acc[ai_][0][m_][n][e] + br[n][e]), ig = sigmoidf_(acc[ai_][1][m_][n][e] + bi[n][e]); \
                const float l = cv[n][e] * r; la[n][e] = l; xi[n][e] = sqrtf(one_minus_exp(2.0f * l)) * ig * uf[4 * n + e]; } \
            const size_t off = ((size_t)d * ROWS + row_) * DM + ch0; *(u32x4*)(LA + off) = pk8(la[0], la[1]); *(u32x4*)(XI + off) = pk8(xi[0], xi[1]); } while (0)
        EG_LOAD(ua, 0);
        EG_LOAD(ub, 1); EG_DO(ua, 0); EG_LOAD(ua, 2); EG_DO(ub, 1); EG_LOAD(ub, 3); EG_DO(ua, 2); EG_LOAD(ua, 4); EG_DO(ub, 3);
        EG_LOAD(ub, 5); EG_DO(ua, 4); EG_LOAD(ua, 6); EG_DO(ub, 5); EG_LOAD(ub, 7); EG_DO(ua, 6); EG_DO(ub, 7);
#undef EG_LOAD
#undef EG_DO
    }
};
struct GateOrder : StaticOrder { __device__ __forceinline__ int a_koff(const Unit& u) const { return ((u.pn & 15) >> 1) * 256; } };

template <class Epi, class Sched, bool ALIGN_EPI = false, bool SP2 = false>
__device__ __forceinline__ void gemm_phase(PG8_LAS unsigned char* lds, const Gemm g, const Sched& S, const Epi& E) {
    int tid = threadIdx.x; asm volatile("" : "+v"(tid));
    const int wid = __builtin_amdgcn_readfirstlane(tid >> 6), lane = tid & 63, wr = wid >> 2, wc = wid & 3, fr = lane & 15, fq = lane >> 4;
    int K = g.K, lda = g.lda; asm volatile("" : "+s"(K), "+s"(lda));
    const int nt = K / BK;
    unsigned voffA[2], voffB[2];
#pragma unroll
    for (int i = 0; i < 2; ++i) { int R, C; stage_rc(tid * 16 + i * 8192, R, C); const int Rb = Epi::PERM ? ((R & ~31) + perm32(R & 31)) : R;
        voffA[i] = (unsigned)(R * lda + C) * 2u; voffB[i] = (unsigned)(Rb * K + C) * 2u; }
    const size_t kstep = (size_t)(BK * 2);
    const size_t hstepA = (size_t)HALF * lda * 2, hstepB = (size_t)HALF * K * 2;
    const size_t tstepA = 2 * hstepA, tstepB = 2 * hstepB;
    const unsigned ldsw = (unsigned)wid * 1024u;
    const int aoff = lds_byte(wr * 64 + fr, fq * 8), boff = lds_byte(wc * 32 + fr, fq * 8);
#define PG8_SA(b, h) (((b) * 2 + (h)) * HTB)
#define PG8_SB(b, h) ((4 + (b) * 2 + (h)) * HTB)
#define PG8_STAGE(bufoff, gbase, voff) do { _Pragma("unroll") for (int _i = 0; _i < 2; ++_i) \
        __builtin_amdgcn_global_load_lds((const unsigned*)((const char*)(gbase) + (voff)[_i]), (PG8_LAS unsigned*)(lds + (bufoff) + ldsw + _i * 8192), 16, 0, 0); } while (0)
#define PG8_LDA(dst, b, h) do { _Pragma("unroll") for (int m = 0; m < 4; ++m) _Pragma("unroll") for (int k = 0; k < 2; ++k) dst[m][k] = *(const PG8_LAS bf16x8*)(lds + PG8_SA(b, h) + aoff + m * 2048 + k * 1024); } while (0)
#define PG8_LDB(dst, b, h) do { _Pragma("unroll") for (int n = 0; n < 2; ++n) _Pragma("unroll") for (int k = 0; k < 2; ++k) dst[n][k] = *(const PG8_LAS bf16x8*)(lds + PG8_SB(b, h) + boff + n * 2048 + k * 1024); } while (0)
#define PG8_MMA(ai, bj, At, Bt) do { __builtin_amdgcn_s_setprio(1); _Pragma("unroll") for (int m = 0; m < 4; ++m) _Pragma("unroll") for (int n = 0; n < 2; ++n) _Pragma("unroll") for (int k = 0; k < 2; ++k) \
        acc[ai][bj][m][n] = __builtin_amdgcn_mfma_f32_16x16x32_bf16(Bt[n][k], At[m][k], acc[ai][bj][m][n], 0, 0, 0); __builtin_amdgcn_s_setprio(0); } while (0)
#define PG8_WAIT_V(n) asm volatile("s_waitcnt vmcnt(" #n ")" ::: "memory")
#define PG8_WAIT_L(n) asm volatile("s_waitcnt lgkmcnt(" #n ")" ::: "memory")
#define PG8_BAR __builtin_amdgcn_s_barrier()
#define PG8_SCHED __builtin_amdgcn_sched_barrier(0)
    Unit cur, nxt; int ui = 0;
    if (!S.next(0, cur)) return;
    f32x4 acc[2][2][4][2];
#pragma unroll
    for (int a = 0; a < 2; ++a)
#pragma unroll
        for (int b = 0; b < 2; ++b)
#pragma unroll
            for (int m = 0; m < 4; ++m)
#pragma unroll
                for (int n = 0; n < 2; ++n) acc[a][b][m][n] = (f32x4){0.f, 0.f, 0.f, 0.f};
    bf16x8 At[4][2], B0[2][2], B1[2][2];
    const char* cA = (const char*)g.A + (size_t)cur.pm * tstepA + (size_t)S.a_koff(cur) * 2; const char* cB = (const char*)g.Bt + (size_t)cur.pn * tstepB;
    S.a_ready(cur); E.prep(cur, lds + TAB_OFF, tid);
    if constexpr (SP2) {
        PG8_STAGE(PG8_SB(0, 0), cB, voffB); PG8_STAGE(PG8_SB(0, 1), cB + hstepB, voffB); PG8_STAGE(PG8_SA(0, 0), cA, voffA); PG8_STAGE(PG8_SA(0, 1), cA + hstepA, voffA);
        if (wr == 1) PG8_BAR;
        PG8_WAIT_V(2); PG8_BAR;
        PG8_STAGE(PG8_SB(1, 0), cB + kstep, voffB); PG8_STAGE(PG8_SA(1, 0), cA + kstep, voffA); PG8_STAGE(PG8_SB(1, 1), cB + hstepB + kstep, voffB);
        PG8_WAIT_V(6); PG8_BAR;
    } else {
        PG8_STAGE(PG8_SB(0, 0), cB, voffB); PG8_STAGE(PG8_SA(0, 0), cA, voffA); PG8_STAGE(PG8_SB(0, 1), cB + hstepB, voffB); PG8_STAGE(PG8_SA(0, 1), cA + hstepA, voffA);
        if (wr == 1) PG8_BAR;
        PG8_WAIT_V(4); PG8_BAR;
        PG8_STAGE(PG8_SB(1, 0), cB + kstep, voffB); PG8_STAGE(PG8_SA(1, 0), cA + kstep, voffA); PG8_STAGE(PG8_SB(1, 1), cB + hstepB + kstep, voffB);
        PG8_WAIT_V(6); PG8_BAR;
    }
    for (;;) {
        const bool has_next = S.next(ui + 1, nxt);
        const char* nA = has_next ? (const char*)g.A + (size_t)nxt.pm * tstepA + (size_t)S.a_koff(nxt) * 2 : cA; const char* nB = has_next ? (const char*)g.Bt + (size_t)nxt.pn * tstepB : cB;
        for (int t = 0; t < nt; t += 2) {
            const bool last = (t == nt - 2);
            const char* a1 = cA + (size_t)(t + 1) * kstep;
            const char* a2 = last ? nA : cA + (size_t)(t + 2) * kstep; const char* b2 = last ? nB : cB + (size_t)(t + 2) * kstep;
            const char* a3 = a2 + kstep; const char* b3 = b2 + kstep;
            if (last && has_next) { S.a_ready(nxt); E.prep(nxt, lds + TAB_OFF + ((ui + 1) & 1) * TAB_BYTES, tid); }
            if constexpr (SP2) {
            PG8_LDB(B0, 0, 0); PG8_LDB(B1, 0, 1); PG8_SCHED; PG8_LDA(At, 0, 0); PG8_STAGE(PG8_SA(1, 1), a1 + hstepA, voffA);
            PG8_WAIT_V(8); PG8_WAIT_L(0); PG8_BAR; PG8_MMA(0, 0, At, B0); PG8_MMA(0, 1, At, B1); PG8_BAR; PG8_SCHED;
            PG8_LDA(At, 0, 1); PG8_STAGE(PG8_SB(0, 0), b2, voffB); PG8_STAGE(PG8_SB(0, 1), b2 + hstepB, voffB); PG8_STAGE(PG8_SA(0, 0), a2, voffA);
            PG8_WAIT_V(8); PG8_WAIT_L(0); PG8_BAR; PG8_MMA(1, 0, At, B0); PG8_MMA(1, 1, At, B1); PG8_BAR; PG8_SCHED;
            PG8_LDB(B0, 1, 0); PG8_LDB(B1, 1, 1); PG8_SCHED; PG8_LDA(At, 1, 0); PG8_STAGE(PG8_SA(0, 1), a2 + hstepA, voffA);
            PG8_WAIT_V(8); PG8_WAIT_L(0); PG8_BAR; PG8_MMA(0, 0, At, B0); PG8_MMA(0, 1, At, B1); PG8_BAR; PG8_SCHED;
            PG8_LDA(At, 1, 1); PG8_STAGE(PG8_SB(1, 0), b3, voffB); PG8_STAGE(PG8_SB(1, 1), b3 + hstepB, voffB); PG8_STAGE(PG8_SA(1, 0), a3, voffA);
            PG8_WAIT_V(8); PG8_WAIT_L(0); PG8_BAR; PG8_MMA(1, 0, At, B0); PG8_MMA(1, 1, At, B1); PG8_BAR; PG8_SCHED;
            } else {
            PG8_LDB(B0, 0, 0); PG8_SCHED; PG8_LDA(At, 0, 0); PG8_STAGE(PG8_SA(1, 1), a1 + hstepA, voffA);
            PG8_WAIT_L(8); PG8_BAR; PG8_WAIT_L(0); PG8_MMA(0, 0, At, B0); PG8_BAR; PG8_SCHED;
            PG8_LDB(B1, 0, 1); PG8_STAGE(PG8_SB(0, 0), b2, voffB);
            PG8_BAR; PG8_WAIT_L(0); PG8_MMA(0, 1, At, B1); PG8_BAR;
            PG8_LDA(At, 0, 1); PG8_STAGE(PG8_SA(0, 0), a2, voffA);
            PG8_BAR; PG8_WAIT_L(0); PG8_MMA(1, 0, At, B0); PG8_BAR; PG8_SCHED;
            PG8_STAGE(PG8_SB(0, 1), b2 + hstepB, voffB);
            PG8_WAIT_V(6); PG8_BAR; PG8_MMA(1, 1, At, B1); PG8_BAR;
            PG8_LDB(B0, 1, 0); PG8_SCHED; PG8_LDA(At, 1, 0); PG8_STAGE(PG8_SA(0, 1), a2 + hstepA, voffA);
            PG8_WAIT_L(8); PG8_BAR; PG8_WAIT_L(0); PG8_MMA(0, 0, At, B0); PG8_BAR; PG8_SCHED;
            PG8_LDB(B1, 1, 1); PG8_STAGE(PG8_SB(1, 0), b3, voffB);
            PG8_BAR; PG8_WAIT_L(0); PG8_MMA(0, 1, At, B1); PG8_BAR;
            PG8_LDA(At, 1, 1); PG8_STAGE(PG8_SA(1, 0), a3, voffA);
            PG8_BAR; PG8_WAIT_L(0); PG8_MMA(1, 0, At, B0); PG8_BAR; PG8_SCHED;
            PG8_STAGE(PG8_SB(1, 1), b3 + hstepB, voffB);
            PG8_WAIT_V(6); PG8_BAR; PG8_MMA(1, 1, At, B1); PG8_BAR;
            }
        }
        if constexpr (ALIGN_EPI) { if (wr == 0) PG8_BAR; }
        if constexpr (!Epi::AFTER_DRAIN) { E(acc, cur, wr, wc, fr, fq, lds + TAB_OFF + (ui & 1) * TAB_BYTES); S.done(cur); }
        if (!has_next) break;
#pragma unroll
        for (int a = 0; a < 2; ++a)
#pragma unroll
            for (int b = 0; b < 2; ++b)
#pragma unroll
                for (int m = 0; m < 4; ++m)
#pragma unroll
                    for (int n = 0; n < 2; ++n) acc[a][b][m][n] = (f32x4){0.f, 0.f, 0.f, 0.f};
        cur = nxt; cA = nA; cB = nB; ++ui;
        if constexpr (ALIGN_EPI) { if (wr == 1) PG8_BAR; }
    }
    PG8_WAIT_V(0);
    if constexpr (!ALIGN_EPI) { if (wr == 0) PG8_BAR; }
    PG8_BAR;
    if constexpr (Epi::AFTER_DRAIN) { E.fused(acc, cur, wr, wc, fr, fq, lds, wid, lane); S.done(cur); }
#undef PG8_SA
#undef PG8_SB
#undef PG8_STAGE
#undef PG8_LDA
#undef PG8_LDB
#undef PG8_MMA
#undef PG8_WAIT_V
#undef PG8_WAIT_L
#undef PG8_BAR
#undef PG8_SCHED
}
}

#ifndef PG8_SP2
#define PG8_SP2 true
#endif
#ifndef PG8_ALIGN
#define PG8_ALIGN true
#endif
#ifndef MK_ONE_LAUNCH
#define MK_ONE_LAUNCH 1
#endif

constexpr int NWAVES = 8, NTHR = 512;
constexpr int D = 2048, NBATCH = 2, SEQ = 8192, CTXL = 256, DEPTH = 4, FF = 8192, TSEQ = SEQ + CTXL;
constexpr int M = NBATCH * TSEQ;
constexpr int NA_IN = 5 * D, NB_IN = 2 * D, NMOD = 6 * D;
constexpr int NSEG = TSEQ / 32;
constexpr float EPS = 1e-6f;
static_assert(M == pg8::ROWS && D == pg8::DM, "shapes");

constexpr size_t MiB = 1u << 20;
constexpr size_t WS_CTL = 0, CTL_ZERO_BYTES = 1 * MiB;
constexpr size_t WS_MOD = 1 * MiB;
constexpr size_t WS_BIAS1 = 2 * MiB;
constexpr size_t WS_BIAS2 = 3 * MiB;
constexpr size_t WS_LB = 4 * MiB;
constexpr size_t WS_CL = WS_LB + 65536, WS_GM = WS_LB + 131072;
constexpr size_t WS_SSQ = 5 * MiB;
constexpr size_t WS_CP = 8 * MiB, WS_CH = 17 * MiB, WS_CIN = 26 * MiB;
constexpr size_t WS_W = 64 * MiB;
constexpr size_t W_INA = 0, W_OUTA = W_INA + 2ull * NA_IN * D, W_INB = W_OUTA + 2ull * D * D, W_GATE = W_INB + 2ull * NB_IN * D, W_OUTB = W_GATE + 2ull * 32 * 256 * 256,
                 W_1 = W_OUTB + 2ull * D * D, W_2 = W_1 + 4ull * FF * D, W_END = W_2 + 4ull * FF * D;
static_assert(W_END * 2 <= 416 * MiB, "weights region");
constexpr size_t WS_X = 480 * MiB;
constexpr size_t WS_XM = 612 * MiB;
constexpr size_t WS_R0 = 678 * MiB, WS_R1 = 744 * MiB, WS_R2 = 810 * MiB, WS_R3 = 876 * MiB;
constexpr size_t WS_R4 = 942 * MiB;
constexpr size_t WS_R5 = 1206 * MiB;
constexpr size_t WS_R6 = 1338 * MiB;
constexpr size_t WS_END = 1470 * MiB;
constexpr size_t WS_HST = 36 * MiB, WS_GD = 50 * MiB, WS_DECG = 52 * MiB;
constexpr int CW_BAR = 4096;

constexpr int RING_OFF = 0, RING_BYTES = 131072;
constexpr int LDSCTL_OFF = RING_BYTES, MISC_OFF = LDSCTL_OFF + 320;
constexpr int LDS_BYTES = 147456;

#define GAS __attribute__((address_space(1)))
#define LAS __attribute__((address_space(3)))
typedef unsigned short bf16;
typedef float f32x4 __attribute__((ext_vector_type(4)));
typedef float f32x2 __attribute__((ext_vector_type(2)));
typedef short bf16x8 __attribute__((ext_vector_type(8)));
typedef unsigned u32x4 __attribute__((ext_vector_type(4)));
typedef unsigned u32x2 __attribute__((ext_vector_type(2)));
using pg8::pk2; using pg8::pk8; using pg8::bflo; using pg8::bfhi;
#define LDS_WAIT() asm volatile("s_waitcnt lgkmcnt(0)" ::: "memory")

#define XB_TMO      128
#define XB_XCNT(j)  (256  + 64 * (j))
#define XB_XSUB(j)  (1280 + 64 * (j))
#define XB_XGEN(j)  (2304 + 64 * (j))
#define XB_TOP      3328
#define XB_TOPGEN   3392
#define XCD_BAR_WORDS 3456
#define XB_SPIN_CAP (1u << 18)
__device__ __forceinline__ unsigned xb_ld(unsigned* p)              { return __hip_atomic_load(p, __ATOMIC_RELAXED, __HIP_MEMORY_SCOPE_AGENT); }
__device__ __forceinline__ unsigned xb_add(unsigned* p, unsigned v) { return __hip_atomic_fetch_add(p, v, __ATOMIC_RELAXED, __HIP_MEMORY_SCOPE_AGENT); }
__device__ __forceinline__ unsigned xb_xcc_id() { return (unsigned)__builtin_amdgcn_s_getreg((3 << 11) | 20) & 0xFu; }
#define XB_SPIN(cond, bar) do { unsigned _sp = 0; while (cond) { __builtin_amdgcn_s_sleep(1); \
    if ((++_sp & 255u) == 0u) { if (xb_ld(&(bar)[XB_TMO])) break; if (_sp > XB_SPIN_CAP) { atomicAdd(&(bar)[XB_TMO], 1u); break; } } } } while (0)
struct XcdBarrier { unsigned* bar; unsigned x; volatile LAS unsigned* st; };
__device__ __forceinline__ XcdBarrier xcd_barrier_post(unsigned* bar, volatile LAS unsigned* st) {
    XcdBarrier b; b.bar = bar; b.x = xb_xcc_id(); b.st = st;
    if (threadIdx.x == 0) (void)xb_add(&bar[XB_XCNT(b.x)], 1u);
    return b;
}
__device__ __forceinline__ void xcd_barrier_complete(unsigned* bar, unsigned x, unsigned& nloc, unsigned& nx) {
    const unsigned G = gridDim.x * gridDim.y * gridDim.z;
    unsigned sum, cnt, mine, sp = 0u;
    for (;;) {
        sum = 0u; cnt = 0u; mine = 0u;
#pragma unroll
        for (unsigned j = 0; j < 16; ++j) { const unsigned c = xb_ld(&bar[XB_XCNT(j)]); sum += c; cnt += (c > 0u) ? 1u : 0u; mine = (j == x) ? c : mine; }
        if (sum == G) break;
        __builtin_amdgcn_s_sleep(1);
        if ((++sp & 255u) == 0u) { if (xb_ld(&bar[XB_TMO])) break; if (sp > XB_SPIN_CAP) { atomicAdd(&bar[XB_TMO], 1u); break; } }
    }
    nloc = mine > 0u ? mine : 1u; nx = cnt > 0u ? cnt : 1u;
}
__device__ __forceinline__ void xcd_barrier(const XcdBarrier& b) {
    asm volatile("s_waitcnt vmcnt(0)" ::: "memory");
    __syncthreads();
    if (threadIdx.x == 0) {
        unsigned* bar = b.bar;
        __builtin_amdgcn_s_waitcnt(0);
        unsigned nloc = b.st[0], nx = b.st[1];
        if (nloc == 0u) { xcd_barrier_complete(bar, b.x, nloc, nx); b.st[0] = nloc; b.st[1] = nx; }
        const unsigned old = xb_add(&bar[XB_XSUB(b.x)], 1u);
        const unsigned gen = old / nloc;
        if (old + 1u == (gen + 1u) * nloc) {
            __builtin_amdgcn_fence(__ATOMIC_RELEASE, "agent");
            asm volatile("s_waitcnt vmcnt(0)" ::: "memory");
            const unsigned og = xb_add(&bar[XB_TOP], 1u);
            const unsigned tg = og / nx;
            if (og + 1u == (tg + 1u) * nx) xb_add(&bar[XB_TOPGEN], 1u);
            else XB_SPIN(xb_ld(&bar[XB_TOPGEN]) == tg, bar);
            __builtin_amdgcn_fence(__ATOMIC_ACQUIRE, "agent");
            xb_add(&bar[XB_XGEN(b.x)], 1u);
            asm volatile("s_waitcnt vmcnt(0)" ::: "memory");
        } else {
            XB_SPIN(xb_ld(&bar[XB_XGEN(b.x)]) == gen, bar);
            __builtin_amdgcn_fence(__ATOMIC_ACQUIRE, "agent");
            asm volatile("s_waitcnt vmcnt(0)" ::: "memory");
        }
    }
    __syncthreads();
}

__device__ __forceinline__ float wave_sum(float v) {
#pragma unroll
    for (int o = 1; o < 64; o <<= 1) v += __shfl_xor(v, o);
    return v;
}
__device__ __forceinline__ int row_of(int b, int tau) { return tau < CTXL ? b * CTXL + tau : 2 * CTXL + b * SEQ + (tau - CTXL); }
__device__ __forceinline__ float siluf_(float v) { return v / (1.0f + __expf(-v)); }

template <class RowMap>
__device__ __forceinline__ void transpose_item(const float* W, int K, int N, bf16* WT, const RowMap& rm, LAS float* scr, int item, int lane) {
    const int nblk = N / 32, kb = item / nblk, nb = item % nblk, k0 = 64 * kb, n0 = 32 * nb;
#pragma unroll 8
    for (int i = 0; i < 32; ++i) { const int kk = 2 * i + (lane >> 5); scr[kk * 33 + (lane & 31)] = W[(size_t)(k0 + kk) * N + n0 + (lane & 31)]; }
    LDS_WAIT(); asm volatile("" ::: "memory");
    const int c = lane & 7;
#pragma unroll
    for (int j = 0; j < 4; ++j) { const int n = (lane >> 3) + 8 * j; const LAS float* s = scr + (8 * c) * 33 + n;
        u32x4 o; o.x = pk2(s[0 * 33], s[1 * 33]); o.y = pk2(s[2 * 33], s[3 * 33]); o.z = pk2(s[4 * 33], s[5 * 33]); o.w = pk2(s[6 * 33], s[7 * 33]);
        *(GAS u32x4*)(WT + (size_t)rm(n0 + n) * K + k0 + 8 * c) = o; }
    LDS_WAIT(); asm volatile("" ::: "memory");
}
struct RowId { __device__ __forceinline__ int operator()(int n) const { return n; } };
struct RowGate { int d, gi, nblk; __device__ __forceinline__ int operator()(int c) const { return (d * 16 + 2 * nblk + (c >> 7)) * 256 + gi * 128 + (c & 127); } };

__device__ __forceinline__ void p0_mod(LAS unsigned char* lds, const float* c, const float* c_ctx, const float* w_mod, const float* b_mod, float* MOD, int G, int tid) {
    LAS float* sil = (LAS float*)(lds + 81920);
    LAS float* red = (LAS float*)(lds + 106496);
    const int lane = tid & 63, w = tid >> 6;
    bool have = false;
    for (int it = blockIdx.x; it < 192; it += G) {
        if (!have) { for (int i = tid; i < 3 * D; i += NTHR) { const int g = i / D, k = i % D; const float v = g == 0 ? c_ctx[k] : c[(g - 1) * D + k]; sil[i] = siluf_(v); } __syncthreads(); have = true; }
        const int l = it / 48, cb = it % 48, n0 = cb * 256 + lane * 4;
        f32x4 a0 = {0.f, 0.f, 0.f, 0.f}, a1 = a0, a2 = a0;
        const float* wp = w_mod + ((size_t)l * D + w * 256) * NMOD + n0;
#pragma unroll 8
        for (int k = 0; k < 256; ++k) { const f32x4 wv = *(const f32x4*)(wp + (size_t)k * NMOD); const int kk = w * 256 + k; a0 += sil[kk] * wv; a1 += sil[D + kk] * wv; a2 += sil[2 * D + kk] * wv; }
        *(LAS f32x4*)(red + (w * 3 + 0) * 256 + lane * 4) = a0; *(LAS f32x4*)(red + (w * 3 + 1) * 256 + lane * 4) = a1; *(LAS f32x4*)(red + (w * 3 + 2) * 256 + lane * 4) = a2;
        __syncthreads();
        for (int i = tid; i < 768; i += NTHR) { const int g = i >> 8, col = i & 255; float s = 0.f;
#pragma unroll
            for (int w2 = 0; w2 < 8; ++w2) s += red[(w2 * 3 + g) * 256 + col];
            const int n = cb * 256 + col; MOD[(size_t)(l * 3 + g) * NMOD + n] = s + b_mod[(size_t)l * NMOD + n]; }
        __syncthreads();
    }
}
struct RowGen { int mode, d, gi, nblk; __device__ __forceinline__ int operator()(int n) const { return mode ? (d * 16 + 2 * nblk + (n >> 7)) * 256 + gi * 128 + (n & 127) : n; } };
__device__ __forceinline__ void p0_weights(LAS unsigned char* lds, const float* a_w_in, const float* a_w_out, const float* b_w_in, const float* b_gate_w, const float* b_w_out, const float* mlp_w1, const float* mlp_w2,
                                           bf16* Wb, int gw, int NGW, int lane, int wave) {
    LAS float* scr = (LAS float*)(lds + wave * 8448);
    constexpr int I_INA = (D / 64) * (NA_IN / 32), I_DD = (D / 64) * (D / 32), I_INB = (D / 64) * (NB_IN / 32), I_G = 4 * 8, I_1 = (D / 64) * (FF / 32), I_2 = (FF / 64) * (D / 32);
    constexpr int NITEMS = 2 * I_INA + 2 * I_DD + 2 * I_INB + 64 * I_G + 2 * I_DD + 4 * I_1 + 4 * I_2;
    for (int it = gw; it < NITEMS; it += NGW) {
        int r = it; const float* src; bf16* dst; int K, N, item; RowGen rm{0, 0, 0, 0};
        if (r < 2 * I_INA) { const int j = r / I_INA; item = r % I_INA; src = a_w_in + (size_t)j * D * NA_IN; dst = Wb + W_INA + (size_t)j * NA_IN * D; K = D; N = NA_IN; }
        else if ((r -= 2 * I_INA) < 2 * I_DD) { const int j = r / I_DD; item = r % I_DD; src = a_w_out + (size_t)j * D * D; dst = Wb + W_OUTA + (size_t)j * D * D; K = D; N = D; }
        else if ((r -= 2 * I_DD) < 2 * I_INB) { const int j = r / I_INB; item = r % I_INB; src = b_w_in + (size_t)j * D * NB_IN; dst = Wb + W_INB + (size_t)j * NB_IN * D; K = D; N = NB_IN; }
        else if ((r -= 2 * I_INB) < 64 * I_G) { const int mi = r / I_G; item = r % I_G; src = b_gate_w + (size_t)mi * 65536; const int j = mi >> 5; dst = Wb + W_GATE + (size_t)j * 32 * 65536; K = 256; N = 256;
            rm.mode = 1; rm.d = (mi >> 4) & 1; rm.gi = (mi >> 3) & 1; rm.nblk = mi & 7; }
        else if ((r -= 64 * I_G) < 2 * I_DD) { const int j = r / I_DD; item = r % I_DD; src = b_w_out + (size_t)j * D * D; dst = Wb + W_OUTB + (size_t)j * D * D; K = D; N = D; }
        else if ((r -= 2 * I_DD) < 4 * I_1) { const int l = r / I_1; item = r % I_1; src = mlp_w1 + (size_t)l * D * FF; dst = Wb + W_1 + (size_t)l * FF * D; K = D; N = FF; }
        else { r -= 4 * I_1; const int l = r / I_2; item = r % I_2; src = mlp_w2 + (size_t)l * FF * D; dst = Wb + W_2 + (size_t)l * D * FF; K = FF; N = D; }
        transpose_item(src, K, N, dst, rm, scr, item, lane);
    }
}
__device__ __forceinline__ void p0_tables(const float* a_lb, const float* b_lambda, float* LB, float* CL, int gt, int NGT) {
    for (int i = gt; i < 2 * D; i += NGT) { const float l0 = a_lb[i], l1 = a_lb[2 * D + i], mx = fmaxf(l0, l1), e0 = expf(l0 - mx), e1 = expf(l1 - mx); LB[i] = 0.f; LB[2 * D + i] = e1 / (e0 + e1); }
    for (int i = gt; i < 4 * D; i += NGT) CL[i] = -8.0f * log1pf(expf(-b_lambda[i]));
}

__device__ __forceinline__ void p1_phase(const float* xin, const float* ctx, const float* norm1, const float* norm2, const float* MOD, float* GM, float* X, bf16* XM, float* SSQ,
                                         const bf16* Wb, float* BIAS1, float* BIAS2, int gw, int NGW, int gt, int NGT, int lane) {
    for (int i = gt; i < DEPTH * 2 * 3 * D; i += NGT) { const int k = i % D, g = (i / D) % 3, wh = (i / (3 * D)) & 1, l = i / (6 * D);
        GM[i] = (wh ? norm2 : norm1)[l * D + k] * (1.0f + MOD[(size_t)(l * 3 + g) * NMOD + (wh ? 4 : 1) * D + k]); }
    for (int row = gw; row < M; row += NGW) {
        const float* src = row < 2 * CTXL ? ctx + (size_t)row * D : xin + (size_t)(row - 2 * CTXL) * D;
        const int g = row < 2 * CTXL ? 0 : (row < 2 * CTXL + SEQ ? 1 : 2);
        f32x4 v[8]; float ss = 0.f;
#pragma unroll
        for (int j = 0; j < 8; ++j) { v[j] = *(const f32x4*)(src + lane * 4 + 256 * j); ss += (v[j][0] * v[j][0] + v[j][1] * v[j][1]) + (v[j][2] * v[j][2] + v[j][3] * v[j][3]); }
        ss = wave_sum(ss);
#pragma unroll
        for (int j = 0; j < 8; ++j) { const int k = lane * 4 + 256 * j; *(f32x4*)(X + (size_t)row * D + k) = v[j];
            const f32x4 gm = *(const f32x4*)(norm1 + k) * (1.0f + *(const f32x4*)(MOD + (size_t)g * NMOD + D + k)); const f32x4 y = v[j] * gm;
            u32x2 o; o.x = pk2(y[0], y[1]); o.y = pk2(y[2], y[3]); *(u32x2*)(XM + (size_t)row * D + k) = o; }
        if (lane < 32) SSQ[(size_t)row * 32 + lane] = lane == 0 ? ss : 0.f;
    }
    for (int r = gw; r < 2 * NA_IN + 2 * NB_IN + 4 * FF; r += NGW) {
        const bf16* wrow; const float* sh; float* out; int ostride;
        if (r < 2 * NA_IN) { const int j = r / NA_IN, n = r % NA_IN, l = 2 * j; wrow = Wb + W_INA + ((size_t)j * NA_IN + n) * D; sh = MOD + (size_t)l * 3 * NMOD; out = BIAS1 + (size_t)l * 3 * 10240 + n; ostride = 10240; }
        else if (r < 2 * NA_IN + 2 * NB_IN) { const int r2 = r - 2 * NA_IN, j = r2 / NB_IN, n = r2 % NB_IN, l = 2 * j + 1; wrow = Wb + W_INB + ((size_t)j * NB_IN + n) * D; sh = MOD + (size_t)l * 3 * NMOD; out = BIAS1 + (size_t)l * 3 * 10240 + n; ostride = 10240; }
        else { const int r2 = r - 2 * NA_IN - 2 * NB_IN, l = r2 / FF, n = r2 % FF; wrow = Wb + W_1 + ((size_t)l * FF + n) * D; sh = MOD + (size_t)l * 3 * NMOD + 3 * D; out = BIAS2 + (size_t)l * 3 * FF + n; ostride = FF; }
        float s0 = 0.f, s1 = 0.f, s2 = 0.f;
#pragma unroll
        for (int j = 0; j < 4; ++j) { const int k = lane * 8 + 512 * j; const u32x4 ww = *(const u32x4*)(wrow + k);
            const float wf[8] = {bflo(ww.x), bfhi(ww.x), bflo(ww.y), bfhi(ww.y), bflo(ww.z), bfhi(ww.z), bflo(ww.w), bfhi(ww.w)};
#pragma unroll
            for (int e = 0; e < 8; ++e) { s0 += wf[e] * sh[k + e]; s1 += wf[e] * sh[NMOD + k + e]; s2 += wf[e] * sh[2 * NMOD + k + e]; } }
        s0 = wave_sum(s0); s1 = wave_sum(s1); s2 = wave_sum(s2);
        if (lane == 0) { out[0] = s0; out[ostride] = s1; out[2 * ostride] = s2; }
    }
}

constexpr int H3_QT = 0, H3_KT = 8704, H3_KH = 17408, H3_VT = 27648, H3_DEC = 37888, H3_BUF = 38400;
constexpr int HGN = 4, HGC = (TSEQ / 32) / HGN;
static_assert(2 * H3_BUF <= RING_BYTES && HGC * HGN * 32 == TSEQ && (HGC % 2) == 0, "H3 geometry");
__device__ __forceinline__ bf16x8 frag16(const LAS unsigned char* p) { return *(const LAS bf16x8*)p; }
__device__ __forceinline__ bf16x8 frag8x2(const LAS unsigned char* p0, const LAS unsigned char* p1) { const u32x2 a = *(const LAS u32x2*)p0, b = *(const LAS u32x2*)p1; const u32x4 w = {a.x, a.y, b.x, b.y}; return __builtin_bit_cast(bf16x8, w); }
#define MFMA16(a, b, c) __builtin_amdgcn_mfma_f32_16x16x32_bf16((a), (b), (c), 0, 0, 0)
template <bool FULL>
__device__ __forceinline__ void hgrn_phase(LAS unsigned char* lds, const bf16* Q, const bf16* V, const bf16* EB, const bf16* KT, const bf16* KH, const float* DECG, bf16* O, float* HST, float* GD, int G, int tid) {
    const int lane = tid & 63, w = __builtin_amdgcn_readfirstlane(tid >> 6);
    const int c = lane & 15, q4 = lane >> 4, dq = lane & 3, tp = lane >> 2, vi = tid >> 4, vd8 = (tid & 15) * 8, dv0 = 16 * w;
    const int nitems = FULL ? 64 * HGN : 64 * (HGN - 1);
    for (int item = blockIdx.x; item < nitems; item += G) {
        const int chain = FULL ? item / HGN : item / (HGN - 1), g = FULL ? item % HGN : item % (HGN - 1);
        const int b = chain >> 5, dir = (chain >> 4) & 1, h = chain & 15, sgn = dir ? -1 : 1, hoff = h * 128, c0 = g * HGC, c1 = c0 + HGC;
        const size_t dofs = (size_t)dir * M * D;
        f32x4 St[8], gdp[8];
#pragma unroll
        for (int t = 0; t < 8; ++t) { St[t] = (f32x4){0.f, 0.f, 0.f, 0.f}; gdp[t] = (f32x4){1.f, 1.f, 1.f, 1.f}; }
        if (FULL) {
            for (int g2 = 0; g2 < g; ++g2) { const size_t it2 = (size_t)chain * (HGN - 1) + g2;
#pragma unroll
                for (int t = 0; t < 8; ++t) { const f32x4 gv = *(const f32x4*)(GD + it2 * 128 + 16 * t + 4 * q4), hv = *(const f32x4*)(HST + (((it2 * 8 + w) * 8 + t) * 64 + lane) * 4); St[t] = St[t] * gv + hv; } }
        }
        u32x2 eb0A, eb1A, kt0A, kt1A, kh0A, kh1A, qq0A, qq1A, eb0B, eb1B, kt0B, kt1B, kh0B, kh1B, qq0B, qq1B; u32x4 vvA, vvB; f32x4 dcA = {0.f, 0.f, 0.f, 0.f}, dcB = dcA;
#define H3_RBASE(cc) ((32 * (cc) < CTXL) ? (b * CTXL + (dir ? CTXL - 1 - 32 * (cc) : 32 * (cc))) : (2 * CTXL + b * SEQ + (dir ? SEQ - 1 - (32 * (cc) - CTXL) : (32 * (cc) - CTXL))))
#define H3_LOAD(S, cc) do { const int rb_ = H3_RBASE(cc); const int r0_ = rb_ + sgn * (2 * tp), r1_ = r0_ + sgn; const int co_ = hoff + 16 * w + 4 * dq; \
            const size_t o0_ = dofs + (size_t)r0_ * D + co_, o1_ = dofs + (size_t)r1_ * D + co_; \
            kh0##S = *(const u32x2*)(KH + o0_); kh1##S = *(const u32x2*)(KH + o1_); \
            if (FULL) { eb0##S = *(const u32x2*)(EB + o0_); eb1##S = *(const u32x2*)(EB + o1_); kt0##S = *(const u32x2*)(KT + o0_); kt1##S = *(const u32x2*)(KT + o1_); \
                        qq0##S = *(const u32x2*)(Q + (size_t)r0_ * D + co_); qq1##S = *(const u32x2*)(Q + (size_t)r1_ * D + co_); } \
            vv##S = *(const u32x4*)(V + (size_t)(rb_ + sgn * vi) * D + hoff + vd8); \
            if (lane < 4) dc##S = *(const f32x4*)(DECG + ((size_t)dir * (M / 32) + ((dir ? rb_ - 31 : rb_) >> 5)) * D + hoff + 16 * w + 4 * lane); } while (0)
#define H3_PREP(S, bo) do { LAS unsigned char* B_ = lds + (bo); const int dko_ = 16 * w + 4 * dq; \
            if (FULL) { \
                u32x2 o_; o_.x = pk2(bflo(qq0##S.x) * bflo(eb0##S.x), bfhi(qq0##S.x) * bfhi(eb0##S.x)); o_.y = pk2(bflo(qq0##S.y) * bflo(eb0##S.y), bfhi(qq0##S.y) * bfhi(eb0##S.y)); *(LAS u32x2*)(B_ + H3_QT + (2 * tp) * 272 + dko_ * 2) = o_; \
                o_.x = pk2(bflo(qq1##S.x) * bflo(eb1##S.x), bfhi(qq1##S.x) * bfhi(eb1##S.x)); o_.y = pk2(bflo(qq1##S.y) * bflo(eb1##S.y), bfhi(qq1##S.y) * bfhi(eb1##S.y)); *(LAS u32x2*)(B_ + H3_QT + (2 * tp + 1) * 272 + dko_ * 2) = o_; \
                *(LAS u32x2*)(B_ + H3_KT + (2 * tp) * 272 + dko_ * 2) = kt0##S; *(LAS u32x2*)(B_ + H3_KT + (2 * tp + 1) * 272 + dko_ * 2) = kt1##S; } \
            *(LAS unsigned*)(B_ + H3_KH + (dko_ + 0) * 80 + (2 * tp) * 2) = (kh0##S.x & 0xffffu) | (kh1##S.x << 16); \
            *(LAS unsigned*)(B_ + H3_KH + (dko_ + 1) * 80 + (2 * tp) * 2) = (kh0##S.x >> 16) | (kh1##S.x & 0xffff0000u); \
            *(LAS unsigned*)(B_ + H3_KH + (dko_ + 2) * 80 + (2 * tp) * 2) = (kh0##S.y & 0xffffu) | (kh1##S.y << 16); \
            *(LAS unsigned*)(B_ + H3_KH + (dko_ + 3) * 80 + (2 * tp) * 2) = (kh0##S.y >> 16) | (kh1##S.y & 0xffff0000u); \
            if (lane < 4) *(LAS f32x4*)(B_ + H3_DEC + (16 * w + 4 * lane) * 4) = dc##S; \
            { const unsigned vw_[4] = {vv##S.x, vv##S.y, vv##S.z, vv##S.w}; \
              _Pragma("unroll") for (int e = 0; e < 4; ++e) { *(LAS unsigned short*)(B_ + H3_VT + (vd8 + 2 * e) * 80 + vi * 2) = (unsigned short)(vw_[e] & 0xffffu); \
                                                             *(LAS unsigned short*)(B_ + H3_VT + (vd8 + 2 * e + 1) * 80 + vi * 2) = (unsigned short)(vw_[e] >> 16); } } \
        } while (0)
#define H3_MMA(bo, cc) do { const LAS unsigned char* B_ = lds + (bo); \
            if (FULL) { \
            f32x4 X00 = {0.f, 0.f, 0.f, 0.f}, X01 = X00, X11 = X00; \
            _Pragma("unroll") for (int ks = 0; ks < 4; ++ks) { const int ko_ = (32 * ks + 8 * q4) * 2; \
                const bf16x8 a0_ = frag16(B_ + H3_KT + c * 272 + ko_), a1_ = frag16(B_ + H3_KT + (16 + c) * 272 + ko_), b0_ = frag16(B_ + H3_QT + c * 272 + ko_), b1_ = frag16(B_ + H3_QT + (16 + c) * 272 + ko_); \
                X00 = MFMA16(a0_, b0_, X00); X01 = MFMA16(a0_, b1_, X01); X11 = MFMA16(a1_, b1_, X11); } \
            _Pragma("unroll") for (int r_ = 0; r_ < 4; ++r_) if (4 * q4 + r_ > c) { X00[r_] = 0.f; X11[r_] = 0.f; } \
            const bf16x8 va_ = frag8x2(B_ + H3_VT + (dv0 + c) * 80 + 8 * q4, B_ + H3_VT + (dv0 + c) * 80 + 32 + 8 * q4); \
            const u32x4 xw0_ = {pk2(X00[0], X00[1]), pk2(X00[2], X00[3]), 0u, 0u}, xw1_ = {pk2(X01[0], X01[1]), pk2(X01[2], X01[3]), pk2(X11[0], X11[1]), pk2(X11[2], X11[3])}; \
            f32x4 OT0 = {0.f, 0.f, 0.f, 0.f}, OT1 = OT0; \
            OT0 = MFMA16(va_, __builtin_bit_cast(bf16x8, xw0_), OT0); OT1 = MFMA16(va_, __builtin_bit_cast(bf16x8, xw1_), OT1); \
            _Pragma("unroll") for (int ks = 0; ks < 4; ++ks) { const u32x4 sw_ = pk8(St[2 * ks], St[2 * ks + 1]); const bf16x8 sa_ = __builtin_bit_cast(bf16x8, sw_); \
                const int k0_ = (32 * ks + 4 * q4) * 2, k1_ = (32 * ks + 16 + 4 * q4) * 2; \
                const bf16x8 qb0_ = frag8x2(B_ + H3_QT + c * 272 + k0_, B_ + H3_QT + c * 272 + k1_), qb1_ = frag8x2(B_ + H3_QT + (16 + c) * 272 + k0_, B_ + H3_QT + (16 + c) * 272 + k1_); \
                OT0 = MFMA16(sa_, qb0_, OT0); OT1 = MFMA16(sa_, qb1_, OT1); } \
            { const int rb_ = H3_RBASE(cc); u32x2 o0_, o1_; o0_.x = pk2(OT0[0], OT0[1]); o0_.y = pk2(OT0[2], OT0[3]); o1_.x = pk2(OT1[0], OT1[1]); o1_.y = pk2(OT1[2], OT1[3]); \
              *(u32x2*)(O + dofs + (size_t)(rb_ + sgn * c) * D + hoff + dv0 + 4 * q4) = o0_; *(u32x2*)(O + dofs + (size_t)(rb_ + sgn * (16 + c)) * D + hoff + dv0 + 4 * q4) = o1_; } \
            } \
            const bf16x8 vb_ = frag16(B_ + H3_VT + (dv0 + c) * 80 + 16 * q4); \
            _Pragma("unroll") for (int t = 0; t < 8; ++t) { const bf16x8 ka_ = frag16(B_ + H3_KH + (16 * t + c) * 80 + 16 * q4); const f32x4 dec_ = *(const LAS f32x4*)(B_ + H3_DEC + (16 * t + 4 * q4) * 4); \
                St[t] = MFMA16(ka_, vb_, St[t] * dec_); if (!FULL) gdp[t] *= dec_; } \
        } while (0)
        H3_LOAD(A, c0); H3_LOAD(B, c0 + 1);
        __syncthreads();
        H3_PREP(A, 0); H3_LOAD(A, c0 + 2);
        __syncthreads();
        for (int cc = c0; cc < c1; cc += 2) {
            H3_PREP(B, H3_BUF); if (cc + 3 < c1) H3_LOAD(B, cc + 3);
            H3_MMA(0, cc);
            __syncthreads();
            if (cc + 2 < c1) { H3_PREP(A, 0); if (cc + 4 < c1) H3_LOAD(A, cc + 4); }
            H3_MMA(H3_BUF, cc + 1);
            __syncthreads();
        }
        if (!FULL) {
#pragma unroll
            for (int t = 0; t < 8; ++t) { *(f32x4*)(HST + ((((size_t)item * 8 + w) * 8 + t) * 64 + lane) * 4) = St[t]; if (c == 0 && w == 0) *(f32x4*)(GD + (size_t)item * 128 + 16 * t + 4 * q4) = gdp[t]; }
        }
#undef H3_LOAD
#undef H3_PREP
#undef H3_MMA
#undef H3_RBASE
    }
}

__device__ __forceinline__ void a3_phase(const bf16* O, const bf16* SG, const float* onorm, bf16* OG, int gw, int NGW, int lane) {
    for (int it = gw; it < M * 4; it += NGW) { const int row = it >> 2, c8 = (it & 3) * 512 + lane * 8;
        const u32x4 a = *(const u32x4*)(O + (size_t)row * D + c8), b = *(const u32x4*)(O + ((size_t)M + row) * D + c8), s = *(const u32x4*)(SG + (size_t)row * D + c8);
        const f32x4 n0 = *(const f32x4*)(onorm + c8), n1 = *(const f32x4*)(onorm + c8 + 4);
        float o[8] = {bflo(a.x) + bflo(b.x), bfhi(a.x) + bfhi(b.x), bflo(a.y) + bflo(b.y), bfhi(a.y) + bfhi(b.y), bflo(a.z) + bflo(b.z), bfhi(a.z) + bfhi(b.z), bflo(a.w) + bflo(b.w), bfhi(a.w) + bfhi(b.w)};
        const float sg[8] = {bflo(s.x), bfhi(s.x), bflo(s.y), bfhi(s.y), bflo(s.z), bfhi(s.z), bflo(s.w), bfhi(s.w)};
        float ss = 0.f;
#pragma unroll
        for (int e = 0; e < 8; ++e) ss += o[e] * o[e];
        ss += __shfl_xor(ss, 1); ss += __shfl_xor(ss, 2); ss += __shfl_xor(ss, 4); ss += __shfl_xor(ss, 8);
        const float r = 1.0f / sqrtf(ss * (1.0f / 128.0f) + EPS);
#pragma unroll
        for (int e = 0; e < 8; ++e) o[e] = o[e] * r * (e < 4 ? n0[e & 3] : n1[e & 3]) * sg[e];
        u32x4 y; y.x = pk2(o[0], o[1]); y.y = pk2(o[2], o[3]); y.z = pk2(o[4], o[5]); y.w = pk2(o[6], o[7]);
        *(u32x4*)(OG + (size_t)row * D + c8) = y; }
}
__device__ __forceinline__ void conv_phase(const bf16* UP, const float* cw, const float* cb, bf16* U, int gt, int NGT) {
    for (int idx = gt; idx < M * 256; idx += NGT) { const int row = idx >> 8, c8 = (idx & 255) * 8;
        int lo, hi; if (row < 2 * CTXL) { lo = (row / CTXL) * CTXL; hi = lo + CTXL; } else { lo = 2 * CTXL + ((row - 2 * CTXL) / SEQ) * SEQ; hi = lo + SEQ; }
        f32x4 a0 = *(const f32x4*)(cb + c8), a1 = *(const f32x4*)(cb + c8 + 4);
#pragma unroll
        for (int j = 0; j < 4; ++j) { const int rr = row + j - 2;
            if (rr >= lo && rr < hi) { const u32x4 uw = *(const u32x4*)(UP + (size_t)rr * D + c8); const f32x4 w0 = *(const f32x4*)(cw + j * D + c8), w1 = *(const f32x4*)(cw + j * D + c8 + 4);
                a0 += w0 * (f32x4){bflo(uw.x), bfhi(uw.x), bflo(uw.y), bfhi(uw.y)}; a1 += w1 * (f32x4){bflo(uw.z), bfhi(uw.z), bflo(uw.w), bfhi(uw.w)}; } }
        *(u32x4*)(U + (size_t)row * D + c8) = pk8(a0, a1); }
}
__device__ __forceinline__ void r1_phase(const bf16* LA, const bf16* XI, float* CP, float* CH, int gt, int NGT) {
    for (int it = gt; it < 2 * 2 * NSEG * 256; it += NGT) { const int c8 = (it & 255) * 8; int r = it >> 8; const int s = r % NSEG; r /= NSEG; const int dir = r & 1, b = r >> 1;
        const bf16* la = LA + (size_t)dir * M * D + c8; const bf16* xi = XI + (size_t)dir * M * D + c8; const int rb = row_of(b, 32 * s);
        float P[8], H[8];
#pragma unroll
        for (int e = 0; e < 8; ++e) { P[e] = 0.f; H[e] = 0.f; }
#pragma unroll 4
        for (int i = 0; i < 32; ++i) { const int row = rb + (dir ? 31 - i : i); const u32x4 lw = *(const u32x4*)(la + (size_t)row * D), xw = *(const u32x4*)(xi + (size_t)row * D);
            const float l[8] = {bflo(lw.x), bfhi(lw.x), bflo(lw.y), bfhi(lw.y), bflo(lw.z), bfhi(lw.z), bflo(lw.w), bfhi(lw.w)}, x[8] = {bflo(xw.x), bfhi(xw.x), bflo(xw.y), bfhi(xw.y), bflo(xw.z), bfhi(xw.z), bflo(xw.w), bfhi(xw.w)};
#pragma unroll
            for (int e = 0; e < 8; ++e) { P[e] += l[e]; H[e] = __expf(l[e]) * H[e] + x[e]; } }
        const size_t o = ((size_t)(b * 2 + dir) * NSEG + s) * D + c8;
        *(f32x4*)(CP + o) = (f32x4){P[0], P[1], P[2], P[3]}; *(f32x4*)(CP + o + 4) = (f32x4){P[4], P[5], P[6], P[7]};
        *(f32x4*)(CH + o) = (f32x4){H[0], H[1], H[2], H[3]}; *(f32x4*)(CH + o + 4) = (f32x4){H[4], H[5], H[6], H[7]}; }
}
__device__ __forceinline__ void r2_phase(const float* CP, const float* CH, float* CIN, int gt, int NGT) {
    for (int it = gt; it < 2 * 2 * D; it += NGT) { const int ch = it & (D - 1), dir = (it >> 11) & 1, b = it >> 12; const size_t base = (size_t)(b * 2 + dir) * NSEG * D + ch; float h = 0.f;
#pragma unroll 8
        for (int i = 0; i < NSEG; ++i) { const int s = dir ? (i < 8 ? 7 - i : NSEG + 7 - i) : i; const size_t o = base + (size_t)s * D; CIN[o] = h; h = __expf(CP[o]) * h + CH[o]; } }
}
__device__ __forceinline__ void r3_phase(const bf16* LA, const bf16* XI, const bf16* GY, const float* CIN, bf16* HG, int G, int tid) {
    for (int it = blockIdx.x; it < 2 * NSEG; it += G) { const int b = it / NSEG, s = it % NSEG, c4 = tid * 4, rb = row_of(b, 32 * s);
        f32x4 hf[32]; f32x4 h = *(const f32x4*)(CIN + ((size_t)(b * 2 + 0) * NSEG + s) * D + c4);
#pragma unroll
        for (int i = 0; i < 32; ++i) { const size_t o = (size_t)(rb + i) * D + c4; const u32x2 lw = *(const u32x2*)(LA + o), xw = *(const u32x2*)(XI + o);
            const f32x4 l = {bflo(lw.x), bfhi(lw.x), bflo(lw.y), bfhi(lw.y)}, x = {bflo(xw.x), bfhi(xw.x), bflo(xw.y), bfhi(xw.y)};
#pragma unroll
            for (int e = 0; e < 4; ++e) h[e] = __expf(l[e]) * h[e] + x[e];
            hf[i] = h; if ((i & 7) == 7) asm volatile("" ::: "memory"); }
        h = *(const f32x4*)(CIN + ((size_t)(b * 2 + 1) * NSEG + s) * D + c4);
#pragma unroll
        for (int i = 31; i >= 0; --i) { const size_t o = (size_t)(rb + i) * D + c4; const u32x2 lw = *(const u32x2*)(LA + (size_t)M * D + o), xw = *(const u32x2*)(XI + (size_t)M * D + o), gw2 = *(const u32x2*)(GY + o);
            const f32x4 l = {bflo(lw.x), bfhi(lw.x), bflo(lw.y), bfhi(lw.y)}, x = {bflo(xw.x), bfhi(xw.x), bflo(xw.y), bfhi(xw.y)}, g = {bflo(gw2.x), bfhi(gw2.x), bflo(gw2.y), bfhi(gw2.y)};
#pragma unroll
            for (int e = 0; e < 4; ++e) h[e] = __expf(l[e]) * h[e] + x[e];
            const f32x4 y = g * (hf[i] + h); u32x2 ow; ow.x = pk2(y[0], y[1]); ow.y = pk2(y[2], y[3]); *(u32x2*)(HG + o) = ow;
            if ((i & 7) == 0) asm volatile("" ::: "memory"); } }
}
__device__ __forceinline__ void final_phase(const float* X, const float* SSQ, const float* fnorm, float* out, int gw, int NGW, int lane) {
    for (int r = gw; r < NBATCH * SEQ; r += NGW) { const int row = 2 * CTXL + r;
        float s = lane < 32 ? SSQ[(size_t)row * 32 + lane] : 0.f; s = wave_sum(s); const float rs = 1.0f / sqrtf(s * (1.0f / D) + EPS);
#pragma unroll
        for (int j = 0; j < 8; ++j) { const int k = lane * 4 + 256 * j; *(f32x4*)(out + (size_t)r * D + k) = *(const f32x4*)(X + (size_t)row * D + k) * rs * *(const f32x4*)(fnorm + k); } }
}

constexpr int PH_P0 = 0, PH_P1 = 1, PH_PAIR0 = 2, PH_PER_PAIR = 16, PH_FINAL = PH_PAIR0 + 2 * PH_PER_PAIR, NPHASE = PH_FINAL + 1;
struct Args { const float* in[22]; float* out; unsigned char* ws; int ph_lo, ph_hi, li, pad; };
__global__ void __launch_bounds__(NTHR, 2) hyb_fwd(Args args) {
    extern __shared__ __attribute__((aligned(16))) unsigned char lds_raw[];
    LAS unsigned char* lds = (LAS unsigned char*)lds_raw;
    volatile LAS unsigned* MISC = (volatile LAS unsigned*)(lds + MISC_OFF);
    const int G = gridDim.x, NGW = G * NWAVES, NGT = G * NTHR;
#define TIDS() int tid = threadIdx.x; asm volatile("" : "+v"(tid)); const int lane = tid & 63, wave = __builtin_amdgcn_readfirstlane(tid >> 6), gw = blockIdx.x * NWAVES + wave, gt = blockIdx.x * NTHR + tid; (void)lane; (void)gw; (void)gt
    const __attribute__((address_space(4))) Args* ap = (const __attribute__((address_space(4))) Args*)__builtin_amdgcn_kernarg_segment_ptr(); asm volatile("" : "+s"(ap));
#define INP(i) (ap->in[i])
#define WSP(T, off) ((T*)(ap->ws + (off)))
#define in_x INP(0)
#define in_c INP(1)
#define in_ctx INP(2)
#define in_cctx INP(3)
#define w_mod INP(4)
#define b_mod INP(5)
#define norm1 INP(6)
#define norm2 INP(7)
#define a_w_in INP(8)
#define a_lb INP(9)
#define a_onorm INP(10)
#define a_w_out INP(11)
#define b_w_in INP(12)
#define b_conv_w INP(13)
#define b_conv_b INP(14)
#define b_gate_w INP(15)
#define b_gate_b INP(16)
#define b_lambda INP(17)
#define b_w_out INP(18)
#define mlp_w1 INP(19)
#define mlp_w2 INP(20)
#define fnorm INP(21)
#define MOD WSP(float, WS_MOD)
#define BIAS1 WSP(float, WS_BIAS1)
#define BIAS2 WSP(float, WS_BIAS2)
#define LB WSP(float, WS_LB)
#define CL WSP(float, WS_CL)
#define GM WSP(float, WS_GM)
#define SSQ WSP(float, WS_SSQ)
#define CP WSP(float, WS_CP)
#define CH WSP(float, WS_CH)
#define CIN WSP(float, WS_CIN)
#define Wb WSP(bf16, WS_W)
#define X WSP(float, WS_X)
#define XM WSP(bf16, WS_XM)
#define R0 WSP(bf16, WS_R0)
#define R1 WSP(bf16, WS_R1)
#define R2 WSP(bf16, WS_R2)
#define R3 WSP(bf16, WS_R3)
#define KTp WSP(bf16, WS_R4)
#define KHp (WSP(bf16, WS_R4) + (size_t)2 * M * D)
#define EBp WSP(bf16, WS_R6)
#define HST WSP(float, WS_HST)
#define GDp WSP(float, WS_GD)
#define DECG WSP(float, WS_DECG)
#define LA WSP(bf16, WS_R4)
#define XI (WSP(bf16, WS_R4) + (size_t)2 * M * D)
#define HB WSP(bf16, WS_R4)
#define OB WSP(bf16, WS_R5)
    unsigned* ctl = (unsigned*)(ap->ws + WS_CTL);

    for (int u = threadIdx.x; u < (LDS_BYTES - LDSCTL_OFF) / 4; u += NTHR) ((LAS unsigned*)(lds + LDSCTL_OFF))[u] = 0u;
    __syncthreads();
    XcdBarrier bar = xcd_barrier_post(ctl + CW_BAR + ap->li * XCD_BAR_WORDS, MISC + 8);
    const int lo = ap->ph_lo, hi = ap->ph_hi;
#ifndef PHMASK
#define PHMASK 0xFFFFFFFFull
#endif
#define EN(b) (((PHMASK) >> (b)) & 1ull)
#ifndef DUP_H3
#define DUP_H3 1
#endif
#ifndef DUP_A1
#define DUP_A1 1
#endif
#ifndef DUP_A5
#define DUP_A5 1
#endif
#ifndef DUP_B3
#define DUP_B3 1
#endif
#ifndef DUP_THIN
#define DUP_THIN 1
#endif
#ifndef DUP_PRO
#define DUP_PRO 1
#endif
#define IN(k) (lo <= (k) && (k) < hi)
#define SEAM(k) do { if ((k) + 1 < hi) xcd_barrier(bar); } while (0)

    if (EN(0) && IN(PH_P0)) { TIDS();
        for (int rep = 0; rep < DUP_PRO; ++rep) {
        p0_mod(lds, in_c, in_cctx, w_mod, b_mod, MOD, G, tid);
        p0_tables(a_lb, b_lambda, LB, CL, gt, NGT);
        p0_weights(lds, a_w_in, a_w_out, b_w_in, b_gate_w, b_w_out, mlp_w1, mlp_w2, Wb, gw, NGW, lane, wave);
        SEAM(PH_P0);
        }
    }
    if (EN(1) && IN(PH_P1)) { TIDS();
        for (int rep = 0; rep < DUP_PRO; ++rep) {
        p1_phase(in_x, in_ctx, norm1, norm2, MOD, GM, X, XM, SSQ, Wb, BIAS1, BIAS2, gw, NGW, gt, NGT, lane);
        SEAM(PH_P1);
        }
    }
    for (int lp = 0; lp < 2; ++lp) {
        const int pb = PH_PAIR0 + lp * PH_PER_PAIR, la = 2 * lp, lb = 2 * lp + 1;
        if (EN(2) && IN(pb + 0)) {
            pg8::Gemm g{XM, Wb + W_INA + (size_t)lp * NA_IN * D, M, NA_IN, D, D}; pg8::StaticOrder S; S.init(M, NA_IN, G, (int)blockIdx.x);
            pg8::EpiA1 E{SSQ, BIAS1 + (size_t)la * 3 * 10240, LB + (size_t)lp * 2 * D, R0, R1, R2, EBp, KTp, KHp, DECG};
            for (int rep = 0; rep < DUP_A1; ++rep) {
            pg8::gemm_phase<pg8::EpiA1, pg8::StaticOrder, PG8_ALIGN, PG8_SP2>(lds + RING_OFF, g, S, E);
            SEAM(pb + 0); }
        }
        if (EN(3) && IN(pb + 1)) { TIDS(); for (int rep = 0; rep < DUP_H3; ++rep) { hgrn_phase<false>(lds, R0, R1, EBp, KTp, KHp, DECG, OB, HST, GDp, G, tid); SEAM(pb + 1); } }
        if (EN(4) && IN(pb + 2)) { TIDS(); for (int rep = 0; rep < DUP_H3; ++rep) { hgrn_phase<true>(lds, R0, R1, EBp, KTp, KHp, DECG, OB, HST, GDp, G, tid); SEAM(pb + 2); } }
        if (EN(5) && IN(pb + 3)) { TIDS(); for (int rep = 0; rep < DUP_THIN; ++rep) { a3_phase(OB, R2, a_onorm + (size_t)lp * D, R3, gw, NGW, lane); SEAM(pb + 3); } }
        if (EN(6) && IN(pb + 4)) {
            pg8::Gemm g{R3, Wb + W_OUTA + (size_t)lp * D * D, M, D, D, D}; pg8::StaticOrder S; S.init(M, D, G, (int)blockIdx.x);
            pg8::EpiRes E{X, MOD + (size_t)la * 3 * NMOD + 2 * D, GM + (size_t)(la * 2 + 1) * 3 * D, XM, SSQ};
            pg8::gemm_phase<pg8::EpiRes, pg8::StaticOrder, PG8_ALIGN, PG8_SP2>(lds + RING_OFF, g, S, E);
            SEAM(pb + 4);
        }
        if (EN(7) && IN(pb + 5)) {
            pg8::Gemm g{XM, Wb + W_1 + (size_t)la * FF * D, M, FF, D, D}; pg8::StaticOrder S; S.init(M, FF, G, (int)blockIdx.x);
            pg8::EpiMlp1 E{SSQ, BIAS2 + (size_t)la * 3 * FF, HB};
            for (int rep = 0; rep < DUP_A5; ++rep) {
            pg8::gemm_phase<pg8::EpiMlp1, pg8::StaticOrder, PG8_ALIGN, PG8_SP2>(lds + RING_OFF, g, S, E);
            SEAM(pb + 5); }
        }
        if (EN(8) && IN(pb + 6)) {
            pg8::Gemm g{HB, Wb + W_2 + (size_t)la * D * FF, M, D, FF, FF}; pg8::StaticOrder S; S.init(M, D, G, (int)blockIdx.x);
            pg8::EpiRes E{X, MOD + (size_t)la * 3 * NMOD + 5 * D, GM + (size_t)(lb * 2 + 0) * 3 * D, XM, SSQ};
            pg8::gemm_phase<pg8::EpiRes, pg8::StaticOrder, PG8_ALIGN, PG8_SP2>(lds + RING_OFF, g, S, E);
            SEAM(pb + 6);
        }
        if (EN(9) && IN(pb + 7)) {
            pg8::Gemm g{XM, Wb + W_INB + (size_t)lp * NB_IN * D, M, NB_IN, D, D}; pg8::StaticOrder S; S.init(M, NB_IN, G, (int)blockIdx.x);
            pg8::EpiB1 E{SSQ, BIAS1 + (size_t)lb * 3 * 10240, R0, R1};
            pg8::gemm_phase<pg8::EpiB1, pg8::StaticOrder, PG8_ALIGN, PG8_SP2>(lds + RING_OFF, g, S, E);
            SEAM(pb + 7);
        }
        if (EN(10) && IN(pb + 8)) { TIDS(); for (int rep = 0; rep < DUP_THIN; ++rep) { conv_phase(R1, b_conv_w + (size_t)lp * 4 * D, b_conv_b + (size_t)lp * D, R2, gt, NGT); SEAM(pb + 8); } }
        if (EN(11) && IN(pb + 9)) {
            pg8::Gemm g{R2, Wb + W_GATE + (size_t)lp * 32 * 65536, M, 32 * 256, 256, D}; pg8::GateOrder S; S.init(M, 32 * 256, G, (int)blockIdx.x);
            pg8::EpiGate E{b_gate_b + (size_t)lp * 4 * D, CL + (size_t)lp * 2 * D, R2, LA, XI};
            for (int rep = 0; rep < DUP_B3; ++rep) {
            pg8::gemm_phase<pg8::EpiGate, pg8::GateOrder, PG8_ALIGN, PG8_SP2>(lds + RING_OFF, g, S, E);
            SEAM(pb + 9); }
        }
        if (EN(12) && IN(pb + 10)) { TIDS(); for (int rep = 0; rep < DUP_THIN; ++rep) { r1_phase(LA, XI, CP, CH, gt, NGT); SEAM(pb + 10); } }
        if (EN(13) && IN(pb + 11)) { TIDS(); for (int rep = 0; rep < DUP_THIN; ++rep) { r2_phase(CP, CH, CIN, gt, NGT); SEAM(pb + 11); } }
        if (EN(14) && IN(pb + 12)) { TIDS(); for (int rep = 0; rep < DUP_THIN; ++rep) { r3_phase(LA, XI, R0, CIN, R3, G, tid); SEAM(pb + 12); } }
        if (EN(15) && IN(pb + 13)) {
            pg8::Gemm g{R3, Wb + W_OUTB + (size_t)lp * D * D, M, D, D, D}; pg8::StaticOrder S; S.init(M, D, G, (int)blockIdx.x, lb == DEPTH - 1 ? 2 : 0);
            pg8::EpiRes E{X, MOD + (size_t)lb * 3 * NMOD + 2 * D, GM + (size_t)(lb * 2 + 1) * 3 * D, XM, SSQ};
            pg8::gemm_phase<pg8::EpiRes, pg8::StaticOrder, PG8_ALIGN, PG8_SP2>(lds + RING_OFF, g, S, E);
            SEAM(pb + 13);
        }
        if (EN(16) && IN(pb + 14)) {
            pg8::Gemm g{XM, Wb + W_1 + (size_t)lb * FF * D, M, FF, D, D}; pg8::StaticOrder S; S.init(M, FF, G, (int)blockIdx.x, lb == DEPTH - 1 ? 2 : 0);
            pg8::EpiMlp1 E{SSQ, BIAS2 + (size_t)lb * 3 * FF, HB};
            pg8::gemm_phase<pg8::EpiMlp1, pg8::StaticOrder, PG8_ALIGN, PG8_SP2>(lds + RING_OFF, g, S, E);
            SEAM(pb + 14);
        }
        if (EN(17) && IN(pb + 15)) {
            const int ln = lb + 1 < DEPTH ? lb + 1 : lb;
            pg8::Gemm g{HB, Wb + W_2 + (size_t)lb * D * FF, M, D, FF, FF}; pg8::StaticOrder S; S.init(M, D, G, (int)blockIdx.x, lb == DEPTH - 1 ? 2 : 0);
            pg8::EpiRes E{X, MOD + (size_t)lb * 3 * NMOD + 5 * D, GM + (size_t)(ln * 2 + 0) * 3 * D, XM, SSQ};
            pg8::gemm_phase<pg8::EpiRes, pg8::StaticOrder, PG8_ALIGN, PG8_SP2>(lds + RING_OFF, g, S, E);
            SEAM(pb + 15);
        }
    }
    if (EN(18) && IN(PH_FINAL)) { TIDS(); final_phase(X, SSQ, fnorm, ap->out, gw, NGW, lane); }
#undef IN
#undef SEAM
}

extern "C" void kernel_launch(void* const* d_in, const int* in_sizes, int n_in, void* d_out, int out_size, void* d_ws, size_t ws_size, hipStream_t stream) {
    static int grid = 0;
    if (grid == 0) {
        if (n_in != 22 || out_size != NBATCH * SEQ * D || ws_size < WS_END) { fprintf(stderr, "kernel_launch: unexpected shapes (n_in %d, out %d, ws %zu); nothing launched\n", n_in, out_size, ws_size); grid = -1; return; }
        int dev = 0, cus = 0, per_cu = 0;
        if (hipGetDevice(&dev) != hipSuccess || hipDeviceGetAttribute(&cus, hipDeviceAttributeMultiprocessorCount, dev) != hipSuccess) { grid = -1; return; }
        if (hipFuncSetAttribute((const void*)hyb_fwd, hipFuncAttributeMaxDynamicSharedMemorySize, LDS_BYTES) != hipSuccess) { fprintf(stderr, "kernel_launch: hipFuncSetAttribute failed\n"); grid = -1; return; }
        if (hipOccupancyMaxActiveBlocksPerMultiprocessor(&per_cu, (const void*)hyb_fwd, NTHR, LDS_BYTES) != hipSuccess || per_cu < 1) fprintf(stderr, "kernel_launch: occupancy query reports %d\n", per_cu);
        (void)hipGetLastError();
        grid = cus;
    }
    if (grid < 0) return;
    if (hipMemsetAsync((char*)d_ws + WS_CTL, 0, CTL_ZERO_BYTES, stream) != hipSuccess) return;
    Args a{};
    for (int i = 0; i < 22; ++i) a.in[i] = (const float*)d_in[i];
    a.out = (float*)d_out; a.ws = (unsigned char*)d_ws;
#if MK_ONE_LAUNCH
    a.ph_lo = 0; a.ph_hi = NPHASE; a.li = 0;
    hipLaunchKernelGGL(hyb_fwd, dim3(grid), dim3(NTHR), LDS_BYTES, stream, a);
#else
    for (int k = 0; k < NPHASE; ++k) { a.ph_lo = k; a.ph_hi = k + 1; a.li = k;
        hipLaunchKernelGGL(hyb_fwd, dim3(grid), dim3(NTHR), LDS_BYTES, stream, a); }
#endif
}
```
